# Optimizing an MI355X kernel written in HIP

```python
import jax, jax.numpy as jnp
from jax import lax
import numpy as np

D_MODEL = 1024
BATCH = 2
SEQ = 8192
DEPTH = 2

CHUNK = 64
MIX_WIDTH = D_MODEL
CONV_WIDTH_CH = MIX_WIDTH // 2
CONV_HEADS = 8
CONV_K = 3
POOL_WIDTH_CH = MIX_WIDTH - CONV_WIDTH_CH
POOL_WINDOWS = (2, 4, 8, 16)
N_POOL_GROUPS = len(POOL_WINDOWS)
POOL_GC = POOL_WIDTH_CH // N_POOL_GROUPS
IN_COLS = 4 * CONV_WIDTH_CH + 2 * POOL_WIDTH_CH
RMS_EPS = 1e-6

kernel_name = "hybrid_shortconv_pool_sandwich"


def rmsnorm(x, g):
    xf = x.astype(jnp.float32)
    inv = lax.rsqrt(jnp.mean(xf * xf, axis=-1, keepdims=True) + RMS_EPS)
    return (xf * inv).astype(x.dtype) * g


def causal_depthwise_conv3(v, w, b):
    S = v.shape[1]
    vp = jnp.pad(v, ((0, 0), (CONV_K - 1, 0), (0, 0)))
    y = w[0] * vp[:, 0:S] + w[1] * vp[:, 1:S + 1] + w[2] * vp[:, 2:S + 2]
    return y + b


def multiscale_pool(u, w_pool, scale):
    Bz, S, C = u.shape
    uf = u.astype(jnp.float32)
    cs = jnp.cumsum(uf, axis=1)
    count_pos = jnp.arange(1, S + 1, dtype=jnp.float32)[None, :, None]
    outs = []
    for g, w in enumerate(POOL_WINDOWS):
        sl = slice(g * POOL_GC, (g + 1) * POOL_GC)
        csg = cs[..., sl]
        prev = jnp.pad(csg, ((0, 0), (w, 0), (0, 0)))[:, :S]
        mean = (csg - prev) / jnp.minimum(count_pos, float(w))
        outs.append(mean - uf[..., sl])
    p = jnp.concatenate(outs, axis=-1).astype(u.dtype).reshape(Bz, S, N_POOL_GROUPS, POOL_GC)
    y = jnp.einsum('bsgc,gcd->bsgd', p, w_pool).reshape(Bz, S, C)
    return y * scale


def setup_inputs(seed: int = 0) -> dict:
    key = jax.random.key(seed)
    ks = jax.random.split(key, 10)
    f32 = jnp.float32
    x = jax.random.normal(ks[0], (BATCH, SEQ, D_MODEL), f32)
    pre_norm = 1.0 + 0.05 * jax.random.normal(ks[1], (DEPTH, D_MODEL), f32)
    w_in = jax.random.normal(ks[2], (DEPTH, D_MODEL, IN_COLS), f32) * D_MODEL ** -0.5
    conv_w = jax.random.normal(ks[3], (DEPTH, CONV_K, CONV_WIDTH_CH), f32) * CONV_K ** -0.5
    conv_b = 0.02 * jax.random.normal(ks[4], (DEPTH, CONV_WIDTH_CH), f32)
    w_pool = jax.random.normal(ks[5], (DEPTH, N_POOL_GROUPS, POOL_GC, POOL_GC), f32) * POOL_GC ** -0.5
    pool_scale = 1.0 + 0.05 * jax.random.normal(ks[6], (DEPTH, POOL_WIDTH_CH), f32)
    w_out = jax.random.normal(ks[7], (DEPTH, MIX_WIDTH, D_MODEL), f32) * MIX_WIDTH ** -0.5
    post_norm = 1.0 + 0.05 * jax.random.normal(ks[8], (DEPTH, D_MODEL), f32)
    return {"x": x, "pre_norm": pre_norm, "w_in": w_in, "conv_w": conv_w, "conv_b": conv_b,
            "w_pool": w_pool, "pool_scale": pool_scale, "w_out": w_out, "post_norm": post_norm}


def reference(x, pre_norm, w_in, conv_w, conv_b, w_pool, pool_scale, w_out, post_norm):
    A = CONV_WIDTH_CH
    P = POOL_WIDTH_CH
    for l in range(DEPTH):
        hn = rmsnorm(x, pre_norm[l])
        proj = jnp.einsum('bsd,dc->bsc', hn, w_in[l])
        b_a = proj[..., 0:A]
        c_a = proj[..., A:2 * A]
        h_a = proj[..., 2 * A:3 * A]
        z_a = proj[..., 3 * A:4 * A]
        u_b = proj[..., 4 * A:4 * A + P]
        z_b = proj[..., 4 * A + P:4 * A + 2 * P]
        y_a = b_a * causal_depthwise_conv3(c_a * h_a, conv_w[l], conv_b[l])
        y_a = y_a * jax.nn.silu(z_a)
        y_b = multiscale_pool(u_b, w_pool[l], pool_scale[l]) * jax.nn.silu(z_b)
        y = jnp.concatenate([y_a, y_b], axis=-1)
        out = jnp.einsum('bsc,cd->bsd', y, w_out[l])
        x = x + rmsnorm(out, post_norm[l])
    return x
```

```cpp
#include <hip/hip_runtime.h>
#include <cstdio>
#include <cstdint>
#ifndef MK_QUAD
#define MK_QUAD 1
#endif
namespace pg8 {
#define PG8_LAS __attribute__((address_space(3)))
typedef unsigned short bf16_t;
typedef short bf16x8 __attribute__((ext_vector_type(8)));
typedef float f32x4 __attribute__((ext_vector_type(4)));
typedef unsigned u32x4 __attribute__((ext_vector_type(4)));
constexpr int BM = 256, BK = 64, HALF = 128, HTB = HALF * BK * 2  , STAGE_BYTES = 8 * HTB, NXCD = 8, WGM = 8;

__host__ __device__ __forceinline__ int lds_byte(int r, int c) { const int st = (r >> 4) * 2 + (c >> 5), rr = r & 15, cc = c & 31, ob = rr * 64 + cc * 2; return st * 1024 + (ob ^ (((ob >> 9) & 1) << 5)); }
__host__ __device__ __forceinline__ void stage_rc(int b, int& R, int& C) { const int st = b / 1024, sb = b % 1024, swz = sb ^ (((sb >> 9) & 1) << 5); R = (st >> 1) * 16 + swz / 64; C = (st & 1) * 32 + (swz % 64) / 2; }
__host__ __device__ __forceinline__ int perm32(int rho) { const int n = rho >> 4, i = rho & 15; return 8 * (i >> 2) + 4 * n + (i & 3); }

struct Unit { int pm, pn; };
struct Gemm { const bf16_t* A; const bf16_t* Bt; int M, N, K; };

struct StaticOrder {
    int nM, nN, nwg, G, c;
    __host__ __device__ __forceinline__ void init(int M, int N, int G_, int c_) { nM = M / BM; nN = N / BM; nwg = nM * nN; G = G_; c = c_; }
    __host__ __device__ __forceinline__ bool next(int i, Unit& u) const {
        const long L = (long)i * G + c; if (L >= nwg) return false;
        int wgid = (int)L; { const int q = nwg / NXCD, r = nwg % NXCD, xcd = wgid % NXCD, off = wgid / NXCD; wgid = (xcd < r ? xcd * (q + 1) : r * (q + 1) + (xcd - r) * q) + off; }
        const int nig = WGM * nN, gid = wgid / nig, fm = gid * WGM, gsz = (nM - fm) < WGM ? (nM - fm) : WGM;
        u.pm = fm + ((wgid % nig) % gsz); u.pn = (wgid % nig) / gsz; return true;
    }
    __device__ __forceinline__ void a_ready(const Unit&) const {}
    __device__ __forceinline__ void done(const Unit&) const {}
};


typedef unsigned u32x2 __attribute__((ext_vector_type(2)));
__device__ __forceinline__ unsigned cvt_pk_bf16(float lo, float hi) { unsigned r; asm volatile("v_cvt_pk_bf16_f32 %0, %1, %2" : "=v"(r) : "v"(lo), "v"(hi)); return r; }
__device__ __forceinline__ float silu_f(float z) { return z * __builtin_amdgcn_rcpf(1.0f + __expf(-z)); }
__device__ __forceinline__ f32x4 mul_silu4(const f32x4& x, const f32x4& z) {
    const f32x4 t = z * (-1.44269504089f);
    f32x4 e; e[0] = __builtin_amdgcn_exp2f(t[0]); e[1] = __builtin_amdgcn_exp2f(t[1]); e[2] = __builtin_amdgcn_exp2f(t[2]); e[3] = __builtin_amdgcn_exp2f(t[3]);
    const f32x4 d = e + 1.0f;
    f32x4 r; r[0] = __builtin_amdgcn_rcpf(d[0]); r[1] = __builtin_amdgcn_rcpf(d[1]); r[2] = __builtin_amdgcn_rcpf(d[2]); r[3] = __builtin_amdgcn_rcpf(d[3]);
    return (x * z) * r;
}
template <int K> __device__ __forceinline__ float shl_prev(float cur, float prev) {
    const int t = __builtin_amdgcn_update_dpp(0, __float_as_int(prev), 0x120 + K, 0xf, 0xf, false);
    return __int_as_float(__builtin_amdgcn_update_dpp(t, __float_as_int(cur), 0x110 + K, 0xf, 0xf, false));
}
template <int K> __device__ __forceinline__ float shl_zero(float cur) { return __int_as_float(__builtin_amdgcn_update_dpp(0, __float_as_int(cur), 0x110 + K, 0xf, 0xf, true)); }

constexpr int HBS = 132;
constexpr int HB_BYTES = 3 * 16 * HBS * 4;
constexpr int HALO_TILE = 16 * 128;
constexpr int EPI_HB_OFF = STAGE_BYTES, EPI_MISC_OFF = EPI_HB_OFF + 25600, EPI_INV_OFF = EPI_MISC_OFF + 256, EPI_LDS_END = EPI_INV_OFF + 1024;
static_assert(HB_BYTES <= 25600, "halo images");

#ifndef PROF_ID
#define PROF_ID 0
#endif
#ifndef PROF_BLOCK
#define PROF_BLOCK 9
#endif
#ifndef PROF_WAVE
#define PROF_WAVE 0
#endif
#define PROF_SCALE 20u
#ifdef PROF_CLK
#define PROF_NOW() ((unsigned)__builtin_amdgcn_s_memtime())
#else
#define PROF_NOW() ((unsigned)__builtin_amdgcn_s_memrealtime())
#endif
#define PROF_START(n, lds_, wid_) do { if (PROF_ID == (n) && blockIdx.x == PROF_BLOCK && (wid_) == PROF_WAVE) { const unsigned t_ = PROF_NOW(); \
        if ((threadIdx.x & 63) == 0) ((volatile PG8_LAS unsigned*)((lds_) + pg8::EPI_MISC_OFF))[22] = t_; } } while (0)
#define PROF_STOP(n, lds_, wid_) do { if (PROF_ID == (n) && blockIdx.x == PROF_BLOCK && (wid_) == PROF_WAVE) { const unsigned t_ = PROF_NOW(); \
        if ((threadIdx.x & 63) == 0) { volatile PG8_LAS unsigned* m_ = (volatile PG8_LAS unsigned*)((lds_) + pg8::EPI_MISC_OFF); m_[20] = m_[20] + (t_ - m_[22]); } } } while (0)

__device__ __forceinline__ u32x2 mixA_block(const f32x4& gate, const f32x4& chv, const f32x4& prev, const f32x4& w0, const f32x4& w1, const f32x4& w2, const f32x4& cb) {
    f32x4 c1, c2;
#pragma unroll
    for (int j = 0; j < 4; ++j) { c1[j] = shl_prev<1>(chv[j], prev[j]); c2[j] = shl_prev<2>(chv[j], prev[j]); }
    const f32x4 o = gate * (w0 * c2 + w1 * c1 + w2 * chv + cb);
    u32x2 w; w.x = cvt_pk_bf16(o[0], o[1]); w.y = cvt_pk_bf16(o[2], o[3]); return w;
}
__device__ __forceinline__ u32x4 mixB_block(const f32x4 (&cu)[2], const f32x4 (&pu)[2], const f32x4 (&sg)[2], float rc, int w) {
    float o[8];
#pragma unroll
    for (int e = 0; e < 8; ++e) {
        const float uv = cu[e >> 2][e & 3], up = pu[e >> 2][e & 3];
        float s = uv + shl_prev<1>(uv, up);
        if (w >= 4) { float sp = up + shl_zero<1>(up); s += shl_prev<2>(s, sp);
            if (w >= 8) { sp += shl_zero<2>(sp); s += shl_prev<4>(s, sp);
                if (w >= 16) { sp += shl_zero<4>(sp); s += shl_prev<8>(s, sp); } } }
        o[e] = (s * rc - uv) * sg[e >> 2][e & 3];
    }
    u32x4 wv; wv.x = cvt_pk_bf16(o[0], o[1]); wv.y = cvt_pk_bf16(o[2], o[3]); wv.z = cvt_pk_bf16(o[4], o[5]); wv.w = cvt_pk_bf16(o[6], o[7]); return wv;
}
template <int K> __device__ __forceinline__ float shl_zero_fwd(float cur) { return __int_as_float(__builtin_amdgcn_update_dpp(0, __float_as_int(cur), 0x100 + K, 0xf, 0xf, true)); }
template <int K> __device__ __forceinline__ float row_ror(float cur) { return __int_as_float(__builtin_amdgcn_update_dpp(0, __float_as_int(cur), 0x120 + K, 0xf, 0xf, false)); }
template <int W> __device__ __forceinline__ void lead_sums(const f32x4 (&p)[2], f32x4 (&q)[2]) {
#pragma unroll
    for (int e = 0; e < 8; ++e) { float t = p[e >> 2][e & 3]; t += shl_zero_fwd<1>(t); if (W >= 4) t += shl_zero_fwd<2>(t); if (W >= 8) t += shl_zero_fwd<4>(t); if (W >= 16) t += shl_zero_fwd<8>(t); q[e >> 2][e & 3] = t; }
}
template <int W> __device__ __forceinline__ u32x4 mixB_blockT(const f32x4 (&cu)[2], const f32x4 (&pq)[2], const f32x4 (&sg)[2], float rc, float maskf) {
    float o[8];
#pragma unroll
    for (int e = 0; e < 8; ++e) {
        const float uv = cu[e >> 2][e & 3];
        float s = uv + shl_zero<1>(uv); if (W >= 4) s += shl_zero<2>(s); if (W >= 8) s += shl_zero<4>(s); if (W >= 16) s += shl_zero<8>(s);
        s = fmaf(row_ror<W - 1>(pq[e >> 2][e & 3]), maskf, s);
        o[e] = (s * rc - uv) * sg[e >> 2][e & 3];
    }
    u32x4 wv; wv.x = cvt_pk_bf16(o[0], o[1]); wv.y = cvt_pk_bf16(o[2], o[3]); wv.z = cvt_pk_bf16(o[4], o[5]); wv.w = cvt_pk_bf16(o[6], o[7]); return wv;
}
__device__ __forceinline__ void st_sc1_f32x4(float* p, const f32x4& v) {
    __hip_atomic_store((unsigned long long*)p, ((unsigned long long)__float_as_uint(v[1]) << 32) | __float_as_uint(v[0]), __ATOMIC_RELAXED, __HIP_MEMORY_SCOPE_AGENT);
    __hip_atomic_store((unsigned long long*)p + 1, ((unsigned long long)__float_as_uint(v[3]) << 32) | __float_as_uint(v[2]), __ATOMIC_RELAXED, __HIP_MEMORY_SCOPE_AGENT);
}
__device__ __forceinline__ void st_pay_u32x2(void* p, const u32x2& v) {
    *(u32x2*)p = v;
}
__device__ __forceinline__ void st_pay_u32x4(void* p, const u32x4& v) {
    *(u32x4*)p = v;
}
__device__ __forceinline__ void st_pay_f32(float* p, float v) {
    *p = v;
}
__device__ __forceinline__ f32x4 ld_sc1_f32x4(const float* p) {
    const unsigned long long a = __hip_atomic_load((unsigned long long*)p, __ATOMIC_RELAXED, __HIP_MEMORY_SCOPE_AGENT), b = __hip_atomic_load((unsigned long long*)p + 1, __ATOMIC_RELAXED, __HIP_MEMORY_SCOPE_AGENT);
    return (f32x4){__uint_as_float((unsigned)a), __uint_as_float((unsigned)(a >> 32)), __uint_as_float((unsigned)b), __uint_as_float((unsigned)(b >> 32))};
}

struct EpiMix {
    static constexpr bool PERM = false, AFTER_DRAIN = false;
    bf16_t* Y; const float* ssqp; const float* convw; const float* convb; const float* pscale;
    float* halo; unsigned* flags; unsigned* tmo; unsigned epoch;
    unsigned long long* hga;
    __device__ __forceinline__ void sweepA(const unsigned long long* g, bool active, f32x4& v, const Unit& u, int lane) const {
        for (unsigned sp = 0;;) { bool ok = true;
            if (active) {
#pragma unroll
                for (int k = 0; k < 4; ++k) { const unsigned long long x = __hip_atomic_load((unsigned long long*)g + k, __ATOMIC_RELAXED, __HIP_MEMORY_SCOPE_AGENT); v[k] = __uint_as_float((unsigned)x); ok &= ((unsigned)(x >> 32) == epoch); } }
            if (__all(ok)) return;
            __builtin_amdgcn_s_sleep(2);
            if (++sp > (1u << 20)) { if (lane == 0) __hip_atomic_store(tmo, 0x500u | (unsigned)u.pn, __ATOMIC_RELAXED, __HIP_MEMORY_SCOPE_AGENT); return; } }
    }
    __device__ __forceinline__ void wait_flag(const Unit& u, int lane) const {
        unsigned sp = 0; unsigned* fl = flags + ((u.pm - 1) * 12 + u.pn) * 16; const unsigned want = 4u;
        while ((unsigned)__builtin_amdgcn_readfirstlane(__hip_atomic_load(fl, __ATOMIC_RELAXED, __HIP_MEMORY_SCOPE_AGENT)) < want) { __builtin_amdgcn_s_sleep(1);
            if (++sp > (1u << 20)) { if (lane == 0) __hip_atomic_store(tmo, 0x500u | (unsigned)u.pn, __ATOMIC_RELAXED, __HIP_MEMORY_SCOPE_AGENT); break; } }
    }
    __device__ __forceinline__ u32x4 b_block(int g, const f32x4 (&cu)[2], const f32x4 (&pu)[2], const f32x4 (&sg)[2], float rc, int fr) const {
        f32x4 q[2]; u32x4 r;
        if (g == 0) { lead_sums<2>(pu, q); r = mixB_blockT<2>(cu, q, sg, rc, fr < 1 ? 1.0f : 0.0f); }
        else if (g == 1) { lead_sums<4>(pu, q); r = mixB_blockT<4>(cu, q, sg, rc, fr < 3 ? 1.0f : 0.0f); }
        else if (g == 2) { lead_sums<8>(pu, q); r = mixB_blockT<8>(cu, q, sg, rc, fr < 7 ? 1.0f : 0.0f); }
        else { lead_sums<16>(pu, q); r = mixB_blockT<16>(cu, q, sg, rc, fr < 15 ? 1.0f : 0.0f); }
        return r;
    }
    __device__ __forceinline__ void operator()(f32x4 (&acc)[2][2][4][2], const Unit& u, int wr, int wc, int fr, int fq, PG8_LAS unsigned char* lds, int wid, int lane) const {
        asm volatile("" : "+v"(fr), "+v"(fq), "+v"(lane));
        PROF_START(2, lds, wid);
        PG8_LAS float* HB = (PG8_LAS float*)(lds + EPI_HB_OFF);
        PG8_LAS float* INV = (PG8_LAS float*)(lds + EPI_INV_OFF);
        volatile PG8_LAS unsigned* KEY = (volatile PG8_LAS unsigned*)(lds + EPI_MISC_OFF + 64);
        const unsigned key = (epoch << 16) | (unsigned)u.pm;
        if (KEY[0] != key) {
            int t = threadIdx.x; asm volatile("" : "+v"(t));
            if (t < 256) { const f32x4 p = *(const f32x4*)(ssqp + (size_t)(u.pm * BM + t) * 4); INV[t] = rsqrtf(((p[0] + p[1]) + (p[2] + p[3])) * (1.0f / 1024.0f) + 1e-6f); }
            asm volatile("s_waitcnt lgkmcnt(0)" ::: "memory"); __builtin_amdgcn_s_barrier(); asm volatile("" ::: "memory");
            if (t == 0) KEY[0] = key;
        }
        const int rl = wr * 64 + fr, row0 = u.pm * BM + rl;
        const bool need = (u.pm & 31) != 0;
        float* halo_out = halo + (size_t)(u.pn * 64 + u.pm) * HALO_TILE;
        const float* halo_in = halo_out - HALO_TILE;
        unsigned* myflag = flags + (u.pm * 12 + u.pn) * 16;
        float inv[2][4];
#pragma unroll
        for (int ai = 0; ai < 2; ++ai)
#pragma unroll
            for (int m = 0; m < 4; ++m) inv[ai][m] = INV[rl + ai * HALF + m * 16];
        const f32x4 zero = {0.f, 0.f, 0.f, 0.f};
        if (u.pn < 8) {
            const int chl = 16 * wc + 4 * fq, chg = 64 * u.pn + chl;
            const f32x4 w0 = *(const f32x4*)(convw + chg), w1 = *(const f32x4*)(convw + 512 + chg), w2 = *(const f32x4*)(convw + 1024 + chg), cb = *(const f32x4*)(convb + chg);
            unsigned long long* ga = hga + (size_t)(u.pn * 64 + u.pm) * 128 + (fr >= 14 ? (fr - 14) * 64 + chl : 0);
            if (wr == 1 && fr >= 14) { const float s = inv[1][3]; const f32x4 t = (acc[1][0][3][1] * s) * (acc[1][1][3][0] * s);
#pragma unroll
                for (int j = 0; j < 4; ++j) __hip_atomic_store(ga + j, ((unsigned long long)epoch << 32) | __float_as_uint(t[j]), __ATOMIC_RELAXED, __HIP_MEMORY_SCOPE_AGENT); }
#pragma unroll
            for (int ai = 0; ai < 2; ++ai)
#pragma unroll
                for (int m = 0; m < 4; ++m) { const float s = inv[ai][m]; const f32x4 b = acc[ai][0][m][0] * s, c = acc[ai][0][m][1] * s, h = acc[ai][1][m][0] * s, z = acc[ai][1][m][1] * s; f32x4 g;
#pragma unroll
                    for (int j = 0; j < 4; ++j) g[j] = 0.f;
                    acc[ai][0][m][0] = mul_silu4(b, z); acc[ai][0][m][1] = c * h; }
            PROF_STOP(2, lds, wid); PROF_START(3, lds, wid);
            if (fr >= 14) {
                *(PG8_LAS f32x4*)(HB + (wr * 16 + fr) * HBS + chl) = acc[0][0][3][1];
                if (wr == 0) *(PG8_LAS f32x4*)(HB + (32 + fr) * HBS + chl) = acc[1][0][3][1];
            }
            asm volatile("s_waitcnt lgkmcnt(0)" ::: "memory"); __builtin_amdgcn_s_barrier(); asm volatile("" ::: "memory");
            PROF_STOP(3, lds, wid); PROF_START(4, lds, wid);
            u32x2 o[2][4];
            { const f32x4 pv = (fr >= 14) ? *(const PG8_LAS f32x4*)(HB + ((1 + wr) * 16 + fr) * HBS + chl) : zero;
              o[1][0] = mixA_block(acc[1][0][0][0], acc[1][0][0][1], pv, w0, w1, w2, cb); }
#pragma unroll
            for (int m = 1; m < 4; ++m) o[1][m] = mixA_block(acc[1][0][m][0], acc[1][0][m][1], acc[1][0][m - 1][1], w0, w1, w2, cb);
            PROF_STOP(4, lds, wid); PROF_START(5, lds, wid);
            f32x4 pvg = zero;
            if (wr == 1) { if (fr >= 14) pvg = *(const PG8_LAS f32x4*)(HB + fr * HBS + chl); }
            else if (need) sweepA(ga - 128, fr >= 14, pvg, u, lane);
            PROF_STOP(5, lds, wid); PROF_START(6, lds, wid);
#pragma unroll
            for (int m = 1; m < 4; ++m) o[0][m] = mixA_block(acc[0][0][m][0], acc[0][0][m][1], acc[0][0][m - 1][1], w0, w1, w2, cb);
            o[0][0] = mixA_block(acc[0][0][0][0], acc[0][0][0][1], pvg, w0, w1, w2, cb);
            PROF_STOP(6, lds, wid); PROF_START(7, lds, wid);
            bf16_t* yp = Y + (size_t)row0 * 1024 + chg;
#pragma unroll
            for (int ai = 0; ai < 2; ++ai)
#pragma unroll
                for (int m = 0; m < 4; ++m) st_pay_u32x2(yp + (size_t)(ai * HALF + 16 * m) * 1024, o[ai][m]);
            PROF_STOP(7, lds, wid);
        } else {
            const int g = u.pn - 8, dl = 32 * wc + 8 * fq;
            const f32x4 sc0 = *(const f32x4*)(pscale + 128 * g + dl), sc1 = *(const f32x4*)(pscale + 128 * g + dl + 4);
            if (wr == 1) { const float s = inv[1][3]; st_sc1_f32x4(halo_out + fr * 128 + dl, acc[1][0][3][0] * s); st_sc1_f32x4(halo_out + fr * 128 + dl + 4, acc[1][0][3][1] * s); }
#pragma unroll
            for (int ai = 0; ai < 2; ++ai)
#pragma unroll
                for (int m = 0; m < 4; ++m) { const float s = inv[ai][m];
#pragma unroll
                    for (int n = 0; n < 2; ++n) { const f32x4 uu = acc[ai][0][m][n] * s, z = acc[ai][1][m][n] * s; f32x4 sg;
#pragma unroll
                        for (int j = 0; j < 4; ++j) sg[j] = 0.f;
                        acc[ai][0][m][n] = uu; acc[ai][1][m][n] = mul_silu4(n ? sc1 : sc0, z); } }
            PROF_STOP(2, lds, wid); PROF_START(3, lds, wid);
#pragma unroll
            for (int n = 0; n < 2; ++n) {
                *(PG8_LAS f32x4*)(HB + (wr * 16 + fr) * HBS + dl + 4 * n) = acc[0][0][3][n];
                if (wr == 0) *(PG8_LAS f32x4*)(HB + (32 + fr) * HBS + dl + 4 * n) = acc[1][0][3][n];
            }
            asm volatile("s_waitcnt lgkmcnt(0)" ::: "memory"); __builtin_amdgcn_s_barrier(); asm volatile("" ::: "memory");
            if (wr == 1) { asm volatile("s_waitcnt vmcnt(0)" ::: "memory"); if (lane == 0) __hip_atomic_fetch_add(myflag, 1u, __ATOMIC_RELAXED, __HIP_MEMORY_SCOPE_AGENT); }
            const int tpos0 = (u.pm * BM + rl) & 8191;
            const float fw = (float)(2 << g);
#define MIXB_RC(ai, m) (need ? (1.0f / fw) : 1.0f / fminf((float)(tpos0 + (ai) * HALF + (m) * 16 + 1), fw))
            PROF_STOP(3, lds, wid); PROF_START(4, lds, wid);
            u32x4 o[2][4];
            { f32x4 pv[2]; pv[0] = *(const PG8_LAS f32x4*)(HB + ((1 + wr) * 16 + fr) * HBS + dl); pv[1] = *(const PG8_LAS f32x4*)(HB + ((1 + wr) * 16 + fr) * HBS + dl + 4);
              o[1][0] = b_block(g, acc[1][0][0], pv, acc[1][1][0], MIXB_RC(1, 0), fr); }
#pragma unroll
            for (int m = 1; m < 4; ++m) o[1][m] = b_block(g, acc[1][0][m], acc[1][0][m - 1], acc[1][1][m], MIXB_RC(1, m), fr);
            PROF_STOP(4, lds, wid); PROF_START(5, lds, wid);
            f32x4 pvg[2]; pvg[0] = zero; pvg[1] = zero;
            if (wr == 1) { pvg[0] = *(const PG8_LAS f32x4*)(HB + fr * HBS + dl); pvg[1] = *(const PG8_LAS f32x4*)(HB + fr * HBS + dl + 4); }
            else if (need) { wait_flag(u, lane); pvg[0] = ld_sc1_f32x4(halo_in + fr * 128 + dl); pvg[1] = ld_sc1_f32x4(halo_in + fr * 128 + dl + 4); }
            PROF_STOP(5, lds, wid); PROF_START(6, lds, wid);
#pragma unroll
            for (int m = 1; m < 4; ++m) o[0][m] = b_block(g, acc[0][0][m], acc[0][0][m - 1], acc[0][1][m], MIXB_RC(0, m), fr);
            o[0][0] = b_block(g, acc[0][0][0], pvg, acc[0][1][0], MIXB_RC(0, 0), fr);
#undef MIXB_RC
            PROF_STOP(6, lds, wid); PROF_START(7, lds, wid);
            bf16_t* yp = Y + (size_t)row0 * 1024 + 512 + 128 * g + dl;
#pragma unroll
            for (int ai = 0; ai < 2; ++ai)
#pragma unroll
                for (int m = 0; m < 4; ++m) st_pay_u32x4(yp + (size_t)(ai * HALF + 16 * m) * 1024, o[ai][m]);
            PROF_STOP(7, lds, wid);
        }
    }
};

template <int MODE> struct EpiRms {
    static constexpr bool PERM = true, AFTER_DRAIN = true;
    const bf16_t* base_b; float* out_f; bf16_t* out_b; float* ssq_out; const float* gpost;
    unsigned long long* xslot; unsigned* tmo; unsigned tag;
    __device__ __forceinline__ void fused(f32x4 (&acc)[2][2][4][2], const Unit& u, int wr, int wc, int fr, int fq, PG8_LAS unsigned char* lds, int wid, int lane) const {
        PG8_LAS float* P = (PG8_LAS float*)lds;
        PG8_LAS float* S = (PG8_LAS float*)(lds + 4096);
        PROF_START(30, lds, wid);
#pragma unroll
        for (int ai = 0; ai < 2; ++ai)
#pragma unroll
            for (int m = 0; m < 4; ++m) { float s = 0.f;
#pragma unroll
                for (int bj = 0; bj < 2; ++bj)
#pragma unroll
                    for (int n = 0; n < 2; ++n) { const f32x4 x = acc[ai][bj][m][n]; s += (x[0] * x[0] + x[1] * x[1]) + (x[2] * x[2] + x[3] * x[3]); }
                s += __shfl_xor(s, 16); s += __shfl_xor(s, 32);
                if (fq == 0) P[(ai * HALF + wr * 64 + m * 16 + fr) * 4 + wc] = s; }
        asm volatile("s_waitcnt lgkmcnt(0)" ::: "memory"); __builtin_amdgcn_s_barrier(); asm volatile("" ::: "memory");
        PROF_STOP(30, lds, wid); PROF_START(31, lds, wid);
        const int row = wid * 32 + (lane & 31);
        unsigned long long* slot = xslot + (size_t)(u.pm * BM + row) * 4;
        if (lane < 32) { const f32x4 p = *(const PG8_LAS f32x4*)(P + row * 4); const float t = (p[0] + p[1]) + (p[2] + p[3]);
            __hip_atomic_store(slot + u.pn, ((unsigned long long)tag << 32) | __float_as_uint(t), __ATOMIC_RELAXED, __HIP_MEMORY_SCOPE_AGENT); }
        const int col0 = u.pn * BM + wc * 32 + 8 * fq;
        const size_t off0 = (size_t)(u.pm * BM + wr * 64 + fr) * 1024 + col0;
        u32x4 rb[2][4][2];
#define RMS_LOAD_RES(ai) do { _Pragma("unroll") for (int m = 0; m < 4; ++m) _Pragma("unroll") for (int bj = 0; bj < 2; ++bj) \
            rb[ai][m][bj] = *(const u32x4*)(base_b + off0 + (size_t)((ai) * HALF + m * 16) * 1024 + bj * HALF); } while (0)
        RMS_LOAD_RES(0);
        f32x4 gv[2][2];
#pragma unroll
        for (int bj = 0; bj < 2; ++bj)
#pragma unroll
            for (int n = 0; n < 2; ++n) gv[bj][n] = *(const f32x4*)(gpost + col0 + bj * HALF + 4 * n);
        PROF_STOP(31, lds, wid); PROF_START(32, lds, wid);
        if (lane < 32) { float t = 0.f; unsigned sp = 0;
            for (;;) { bool ok = true; t = 0.f;
#pragma unroll
                for (int k = 0; k < 4; ++k) { const unsigned long long g = __hip_atomic_load(slot + k, __ATOMIC_RELAXED, __HIP_MEMORY_SCOPE_AGENT); ok &= ((unsigned)(g >> 32) == tag); t += __uint_as_float((unsigned)g); }
                if (ok) break;
                __builtin_amdgcn_s_sleep(1);
                if (++sp > (1u << 20)) { __hip_atomic_store(tmo, 0x700u | (unsigned)u.pm, __ATOMIC_RELAXED, __HIP_MEMORY_SCOPE_AGENT); break; } }
            S[row] = rsqrtf(t * (1.0f / 1024.0f) + 1e-6f); }
        asm volatile("s_waitcnt lgkmcnt(0)" ::: "memory"); __builtin_amdgcn_s_barrier(); asm volatile("" ::: "memory");
        PROF_STOP(32, lds, wid); PROF_START(33, lds, wid);
        RMS_LOAD_RES(1);
#undef RMS_LOAD_RES
        asm volatile("" ::: "memory");
#pragma unroll
        for (int ai = 0; ai < 2; ++ai)
#pragma unroll
            for (int m = 0; m < 4; ++m) { const int r = ai * HALF + wr * 64 + m * 16 + fr; const float iv = S[r]; const size_t off = off0 + (size_t)(ai * HALF + m * 16) * 1024; float q = 0.f;
#pragma unroll
                for (int bj = 0; bj < 2; ++bj) { const u32x4 bb = rb[ai][m][bj];
                    f32x4 b0, b1; b0[0] = __uint_as_float(bb.x << 16); b0[1] = __uint_as_float(bb.x & 0xffff0000u); b0[2] = __uint_as_float(bb.y << 16); b0[3] = __uint_as_float(bb.y & 0xffff0000u);
                    b1[0] = __uint_as_float(bb.z << 16); b1[1] = __uint_as_float(bb.z & 0xffff0000u); b1[2] = __uint_as_float(bb.w << 16); b1[3] = __uint_as_float(bb.w & 0xffff0000u);
                    const f32x4 o0 = b0 + acc[ai][bj][m][0] * iv * gv[bj][0], o1 = b1 + acc[ai][bj][m][1] * iv * gv[bj][1];
                    if (MODE == 0) { q += ((o0[0] * o0[0] + o0[1] * o0[1]) + (o0[2] * o0[2] + o0[3] * o0[3])) + ((o1[0] * o1[0] + o1[1] * o1[1]) + (o1[2] * o1[2] + o1[3] * o1[3]));
                        u32x4 wv; wv.x = cvt_pk_bf16(o0[0], o0[1]); wv.y = cvt_pk_bf16(o0[2], o0[3]); wv.z = cvt_pk_bf16(o1[0], o1[1]); wv.w = cvt_pk_bf16(o1[2], o1[3]); st_pay_u32x4(out_b + off + bj * HALF, wv); }
                    else { __builtin_nontemporal_store(o0, (f32x4*)(out_f + off + bj * HALF)); __builtin_nontemporal_store(o1, (f32x4*)(out_f + off + bj * HALF + 4)); } }
                if (MODE == 0) { q += __shfl_xor(q, 16); q += __shfl_xor(q, 32); if (fq == 0) P[r * 4 + wc] = q; } }
        PROF_STOP(33, lds, wid); PROF_START(34, lds, wid);
        if (MODE == 0) {
            asm volatile("s_waitcnt lgkmcnt(0)" ::: "memory"); __builtin_amdgcn_s_barrier(); asm volatile("" ::: "memory");
            if (lane < 32) { const f32x4 p = *(const PG8_LAS f32x4*)(P + row * 4); st_pay_f32(ssq_out + (size_t)(u.pm * BM + row) * 4 + u.pn, (p[0] + p[1]) + (p[2] + p[3])); }
        }
    }
};

template <class Epi, class Sched, bool ALIGN_EPI = false, bool SP2 = false>
__device__ __forceinline__ void gemm_phase(PG8_LAS unsigned char* lds, const Gemm g, const Sched& S, const Epi& E) {
    const int tid = threadIdx.x, wid = __builtin_amdgcn_readfirstlane(tid >> 6), lane = tid & 63, wr = wid >> 2, wc = wid & 3, fr = lane & 15, fq = lane >> 4;
    const int K = g.K, nt = K / BK;
    unsigned voffA[2], voffB[2];
#pragma unroll
    for (int i = 0; i < 2; ++i) { int R, C; stage_rc(tid * 16 + i * 8192, R, C); const int Rb = Epi::PERM ? ((R & ~31) + perm32(R & 31)) : R;
        voffA[i] = (unsigned)(R * K + C) * 2u; voffB[i] = (unsigned)(Rb * K + C) * 2u; }
    const size_t kstep = (size_t)(BK * 2);
    const size_t hstep = (size_t)HALF * K * 2;
    const size_t tstep = 2 * hstep;
    const unsigned ldsw = (unsigned)wid * 1024u;
    const int aoff = lds_byte(wr * 64 + fr, fq * 8), boff = lds_byte(wc * 32 + fr, fq * 8);
#define PG8_SA(b, h) (((b) * 2 + (h)) * HTB)
#define PG8_SB(b, h) ((4 + (b) * 2 + (h)) * HTB)
#define PG8_STAGE(bufoff, gbase, voff) do { _Pragma("unroll") for (int _i = 0; _i < 2; ++_i) \
        __builtin_amdgcn_global_load_lds((const unsigned*)((const char*)(gbase) + (voff)[_i]), (PG8_LAS unsigned*)(lds + (bufoff) + ldsw + _i * 8192), 16, 0, 0); } while (0)
#define PG8_LDA(dst, b, h) do { _Pragma("unroll") for (int m = 0; m < 4; ++m) _Pragma("unroll") for (int k = 0; k < 2; ++k) dst[m][k] = *(const PG8_LAS bf16x8*)(lds + PG8_SA(b, h) + aoff + m * 2048 + k * 1024); } while (0)
#define PG8_LDB(dst, b, h) do { _Pragma("unroll") for (int n = 0; n < 2; ++n) _Pragma("unroll") for (int k = 0; k < 2; ++k) dst[n][k] = *(const PG8_LAS bf16x8*)(lds + PG8_SB(b, h) + boff + n * 2048 + k * 1024); } while (0)
#define PG8_MMA(ai, bj, At, Bt) do { __builtin_amdgcn_s_setprio(1); _Pragma("unroll") for (int m = 0; m < 4; ++m) _Pragma("unroll") for (int n = 0; n < 2; ++n) _Pragma("unroll") for (int k = 0; k < 2; ++k) \
        acc[ai][bj][m][n] = __builtin_amdgcn_mfma_f32_16x16x32_bf16(Bt[n][k], At[m][k], acc[ai][bj][m][n], 0, 0, 0); __builtin_amdgcn_s_setprio(0); } while (0)
#define PG8_WAIT_V(n) asm volatile("s_waitcnt vmcnt(" #n ")" ::: "memory")
#define PG8_WAIT_L(n) asm volatile("s_waitcnt lgkmcnt(" #n ")" ::: "memory")
#define PG8_BAR __builtin_amdgcn_s_barrier()
#define PG8_SCHED __builtin_amdgcn_sched_barrier(0)
    PROF_START(22, lds, wid);
    Unit cur, nxt; int ui = 0;
    if (!S.next(0, cur)) return;
    f32x4 acc[2][2][4][2];
#pragma unroll
    for (int a = 0; a < 2; ++a)
#pragma unroll
        for (int b = 0; b < 2; ++b)
#pragma unroll
            for (int m = 0; m < 4; ++m)
#pragma unroll
                for (int n = 0; n < 2; ++n) acc[a][b][m][n] = (f32x4){0.f, 0.f, 0.f, 0.f};
    bf16x8 At[4][2], B0[2][2], B1[2][2];
    const char* cA = (const char*)g.A + (size_t)cur.pm * tstep; const char* cB = (const char*)g.Bt + (size_t)cur.pn * tstep;
    S.a_ready(cur);
    if constexpr (SP2) {
        PG8_STAGE(PG8_SB(0, 0), cB, voffB); PG8_STAGE(PG8_SB(0, 1), cB + hstep, voffB); PG8_STAGE(PG8_SA(0, 0), cA, voffA); PG8_STAGE(PG8_SA(0, 1), cA + hstep, voffA);
        if (wr == 1) PG8_BAR;
        PG8_WAIT_V(2); PG8_BAR;
        PG8_STAGE(PG8_SB(1, 0), cB + kstep, voffB); PG8_STAGE(PG8_SA(1, 0), cA + kstep, voffA); PG8_STAGE(PG8_SB(1, 1), cB + hstep + kstep, voffB);
        PG8_WAIT_V(6); PG8_BAR;
    } else {
        PG8_STAGE(PG8_SB(0, 0), cB, voffB); PG8_STAGE(PG8_SA(0, 0), cA, voffA); PG8_STAGE(PG8_SB(0, 1), cB + hstep, voffB); PG8_STAGE(PG8_SA(0, 1), cA + hstep, voffA);
        if (wr == 1) PG8_BAR;
        PG8_WAIT_V(4); PG8_BAR;
        PG8_STAGE(PG8_SB(1, 0), cB + kstep, voffB); PG8_STAGE(PG8_SA(1, 0), cA + kstep, voffA); PG8_STAGE(PG8_SB(1, 1), cB + hstep + kstep, voffB);
        PG8_WAIT_V(6); PG8_BAR;
    }
    PROF_STOP(22, lds, wid);
    for (;;) {
        const bool has_next = S.next(ui + 1, nxt);
        const char* nA = has_next ? (const char*)g.A + (size_t)nxt.pm * tstep : cA; const char* nB = has_next ? (const char*)g.Bt + (size_t)nxt.pn * tstep : cB;
        PROF_START(8, lds, wid);
        for (int t = 0; t < nt; t += 2) {
            const bool last = (t == nt - 2);
            const char* a1 = cA + (size_t)(t + 1) * kstep;
            const char* a2 = last ? nA : cA + (size_t)(t + 2) * kstep; const char* b2 = last ? nB : cB + (size_t)(t + 2) * kstep;
            const char* a3 = a2 + kstep; const char* b3 = b2 + kstep;
            if (last && has_next) S.a_ready(nxt);
            if constexpr (SP2) {
            PG8_LDB(B0, 0, 0); PG8_LDB(B1, 0, 1); PG8_SCHED; PG8_LDA(At, 0, 0); PG8_STAGE(PG8_SA(1, 1), a1 + hstep, voffA);
            PG8_WAIT_V(8); PG8_WAIT_L(0); PG8_BAR; PG8_MMA(0, 0, At, B0); PG8_MMA(0, 1, At, B1); PG8_BAR; PG8_SCHED;
            PG8_LDA(At, 0, 1); PG8_STAGE(PG8_SB(0, 0), b2, voffB); PG8_STAGE(PG8_SB(0, 1), b2 + hstep, voffB); PG8_STAGE(PG8_SA(0, 0), a2, voffA);
            PG8_WAIT_V(8); PG8_WAIT_L(0); PG8_BAR; PG8_MMA(1, 0, At, B0); PG8_MMA(1, 1, At, B1); PG8_BAR; PG8_SCHED;
            PG8_LDB(B0, 1, 0); PG8_LDB(B1, 1, 1); PG8_SCHED; PG8_LDA(At, 1, 0); PG8_STAGE(PG8_SA(0, 1), a2 + hstep, voffA);
            PG8_WAIT_V(8); PG8_WAIT_L(0); PG8_BAR; PG8_MMA(0, 0, At, B0); PG8_MMA(0, 1, At, B1); PG8_BAR; PG8_SCHED;
            PG8_LDA(At, 1, 1); PG8_STAGE(PG8_SB(1, 0), b3, voffB); PG8_STAGE(PG8_SB(1, 1), b3 + hstep, voffB); PG8_STAGE(PG8_SA(1, 0), a3, voffA);
            PG8_WAIT_V(8); PG8_WAIT_L(0); PG8_BAR; PG8_MMA(1, 0, At, B0); PG8_MMA(1, 1, At, B1); PG8_BAR; PG8_SCHED;
            } else {
            PG8_LDB(B0, 0, 0); PG8_SCHED; PG8_LDA(At, 0, 0); PG8_STAGE(PG8_SA(1, 1), a1 + hstep, voffA);
            PG8_WAIT_L(8); PG8_BAR; PG8_WAIT_L(0); PG8_MMA(0, 0, At, B0); PG8_BAR; PG8_SCHED;
            PG8_LDB(B1, 0, 1); PG8_STAGE(PG8_SB(0, 0), b2, voffB);
            PG8_BAR; PG8_WAIT_L(0); PG8_MMA(0, 1, At, B1); PG8_BAR;
            PG8_LDA(At, 0, 1); PG8_STAGE(PG8_SA(0, 0), a2, voffA);
            PG8_BAR; PG8_WAIT_L(0); PG8_MMA(1, 0, At, B0); PG8_BAR; PG8_SCHED;
            PG8_STAGE(PG8_SB(0, 1), b2 + hstep, voffB);
            PG8_WAIT_V(6); PG8_BAR; PG8_MMA(1, 1, At, B1); PG8_BAR;
            PG8_LDB(B0, 1, 0); PG8_SCHED; PG8_LDA(At, 1, 0); PG8_STAGE(PG8_SA(0, 1), a2 + hstep, voffA);
            PG8_WAIT_L(8); PG8_BAR; PG8_WAIT_L(0); PG8_MMA(0, 0, At, B0); PG8_BAR; PG8_SCHED;
            PG8_LDB(B1, 1, 1); PG8_STAGE(PG8_SB(1, 0), b3, voffB);
            PG8_BAR; PG8_WAIT_L(0); PG8_MMA(0, 1, At, B1); PG8_BAR;
            PG8_LDA(At, 1, 1); PG8_STAGE(PG8_SA(1, 0), a3, voffA);
            PG8_BAR; PG8_WAIT_L(0); PG8_MMA(1, 0, At, B0); PG8_BAR; PG8_SCHED;
            PG8_STAGE(PG8_SB(1, 1), b3 + hstep, voffB);
            PG8_WAIT_V(6); PG8_BAR; PG8_MMA(1, 1, At, B1); PG8_BAR;
            }
        }
        PROF_STOP(8, lds, wid); PROF_START(14, lds, wid);
        if constexpr (ALIGN_EPI) { if (wr == 0) PG8_BAR; }
        PROF_STOP(14, lds, wid); PROF_START(1, lds, wid);
        if constexpr (!Epi::AFTER_DRAIN) { E(acc, cur, wr, wc, fr, fq, lds, wid, lane); S.done(cur); }
        PROF_STOP(1, lds, wid);
        if (!has_next) break;
#pragma unroll
        for (int a = 0; a < 2; ++a)
#pragma unroll
            for (int b = 0; b < 2; ++b)
#pragma unroll
                for (int m = 0; m < 4; ++m)
#pragma unroll
                    for (int n = 0; n < 2; ++n) acc[a][b][m][n] = (f32x4){0.f, 0.f, 0.f, 0.f};
        cur = nxt; cA = nA; cB = nB; ++ui;
        if constexpr (ALIGN_EPI) { if (wr == 1) PG8_BAR; }
    }
    PROF_START(23, lds, wid);
    PG8_WAIT_V(0);
    if constexpr (!ALIGN_EPI) { if (wr == 0) PG8_BAR; }
    PG8_BAR;
    PROF_STOP(23, lds, wid); PROF_START(11, lds, wid);
    if constexpr (Epi::AFTER_DRAIN) { E.fused(acc, cur, wr, wc, fr, fq, lds, wid, lane); S.done(cur); }
    PROF_STOP(11, lds, wid);
#undef PG8_SA
#undef PG8_SB
#undef PG8_STAGE
#undef PG8_LDA
#undef PG8_LDB
#undef PG8_MMA
#undef PG8_WAIT_V
#undef PG8_WAIT_L
#undef PG8_BAR
#undef PG8_SCHED
}
}

constexpr int NWAVES = 8;
#ifndef MK_N_LAUNCHES
#define MK_N_LAUNCHES 1
#endif
constexpr int N_LAUNCHES = MK_N_LAUNCHES;
constexpr int N_PHASES = 5;

constexpr int D = 1024, BATCH = 2, SEQ = 8192, DEPTH = 2, M = BATCH * SEQ, NIN = 3072;
constexpr size_t MiB = 1u << 20;
constexpr size_t WS_CTL = 0, CTL_ZERO_BYTES = 192 * 1024;
constexpr size_t WS_W1T = 2 * MiB;
constexpr size_t WS_W2T = 14 * MiB;
constexpr size_t WS_SSQ = 18 * MiB;
constexpr size_t WS_XSLOT = 19 * MiB;
constexpr size_t WS_HALO = 20 * MiB;
constexpr size_t WS_XB = 32 * MiB;
constexpr size_t WS_Y = 64 * MiB;
constexpr size_t WS_HGA = 96 * MiB;
constexpr size_t WS_END = 97 * MiB;
constexpr int CW_TMO = 0, CW_BAR = 4096, CW_CNT = 8192, CW_XCC = 12288, CW_FLAG = 16384;
static_assert((CW_FLAG + 2 * 768 * 16) * 4 <= (int)CTL_ZERO_BYTES, "ctl words inside the memset region");

constexpr int RING_BYTES = 131072;
constexpr int HB_OFF = RING_BYTES;
constexpr int MISC_OFF = pg8::EPI_MISC_OFF;
constexpr int LDS_BYTES = pg8::EPI_LDS_END;
constexpr int SCR_STRIDE = 17408;
static_assert(pg8::HB_BYTES <= 25600 && 8 * SCR_STRIDE <= MISC_OFF && LDS_BYTES <= 160 * 1024, "LDS map");

#define GAS __attribute__((address_space(1)))
#define LAS __attribute__((address_space(3)))
typedef unsigned short bf16;
typedef unsigned v4u __attribute__((ext_vector_type(4)));
typedef unsigned v2u __attribute__((ext_vector_type(2)));
typedef float f32x4 __attribute__((ext_vector_type(4)));
typedef float f32x16 __attribute__((ext_vector_type(16)));
#define LDS_WAIT() asm volatile("s_waitcnt lgkmcnt(0)" ::: "memory")
#define VM_WAIT() asm volatile("s_waitcnt vmcnt(0)" ::: "memory")
__device__ __forceinline__ unsigned f2bf(float f) { unsigned u = __builtin_bit_cast(unsigned, f); return (u + 0x7fffu + ((u >> 16) & 1u)) >> 16; }
__device__ __forceinline__ unsigned pk2(float lo, float hi) { return f2bf(lo) | (f2bf(hi) << 16); }

#define XB_TMO      128
#define XB_XCNT(j)  (256  + 64 * (j))
#define XB_XSUB(j)  (1280 + 64 * (j))
#define XB_XGEN(j)  (2304 + 64 * (j))
#define XB_TOP      3328
#define XB_TOPGEN   3392
#define XCD_BAR_WORDS 3456
#define XB_SPIN_CAP (1u << 18)

__device__ __forceinline__ unsigned xb_ld(unsigned* p)              { return __hip_atomic_load(p, __ATOMIC_RELAXED, __HIP_MEMORY_SCOPE_AGENT); }
__device__ __forceinline__ unsigned xb_add(unsigned* p, unsigned v) { return __hip_atomic_fetch_add(p, v, __ATOMIC_RELAXED, __HIP_MEMORY_SCOPE_AGENT); }
__device__ __forceinline__ unsigned xb_xcc_id() { return (unsigned)__builtin_amdgcn_s_getreg((3 << 11) | 20) & 0xFu; }
#define XB_SPIN(cond, bar) do { unsigned _sp = 0; while (cond) { __builtin_amdgcn_s_sleep(1); \
    if ((++_sp & 255u) == 0u) { if (xb_ld(&(bar)[XB_TMO])) break; if (_sp > XB_SPIN_CAP) { atomicAdd(&(bar)[XB_TMO], 1u); break; } } } } while (0)

struct XcdBarrier {
    unsigned* bar; unsigned x;
    volatile LAS unsigned* st;
};

__device__ __forceinline__ XcdBarrier xcd_barrier_post(unsigned* bar, volatile LAS unsigned* st) {
    XcdBarrier b; b.bar = bar; b.x = xb_xcc_id(); b.st = st;
    if (threadIdx.x == 0) (void)xb_add(&bar[XB_XCNT(b.x)], 1u);
    return b;
}
__device__ __forceinline__ void xcd_barrier_complete(unsigned* bar, unsigned x, unsigned& nloc, unsigned& nx) {
    const unsigned G = gridDim.x * gridDim.y * gridDim.z;
    unsigned sum, cnt, mine, sp = 0u;
    for (;;) {
        sum = 0u; cnt = 0u; mine = 0u;
#pragma unroll
        for (unsigned j = 0; j < 16; ++j) { const unsigned c = xb_ld(&bar[XB_XCNT(j)]); sum += c; cnt += (c > 0u) ? 1u : 0u; mine = (j == x) ? c : mine; }
        if (sum == G) break;
        __builtin_amdgcn_s_sleep(1);
        if ((++sp & 255u) == 0u) { if (xb_ld(&bar[XB_TMO])) break; if (sp > XB_SPIN_CAP) { atomicAdd(&bar[XB_TMO], 1u); break; } }
    }
    nloc = mine > 0u ? mine : 1u; nx = cnt > 0u ? cnt : 1u;
}

__device__ __forceinline__ void xcd_barrier(const XcdBarrier& b, bool leader_wb = true, bool self_wb = false) {
    asm volatile("s_waitcnt vmcnt(0)" ::: "memory");
    __syncthreads();
    if (threadIdx.x == 0) {
        unsigned* bar = b.bar;
        if (self_wb) { __builtin_amdgcn_fence(__ATOMIC_RELEASE, "agent"); asm volatile("s_waitcnt vmcnt(0)" ::: "memory"); }
        __builtin_amdgcn_s_waitcnt(0);
        unsigned nloc = b.st[0], nx = b.st[1];
        if (nloc == 0u) { xcd_barrier_complete(bar, b.x, nloc, nx); b.st[0] = nloc; b.st[1] = nx; }
        const unsigned old = xb_add(&bar[XB_XSUB(b.x)], 1u);
        const unsigned gen = old / nloc;
        if (old + 1u == (gen + 1u) * nloc) {
            if (leader_wb) __builtin_amdgcn_fence(__ATOMIC_RELEASE, "agent");
            asm volatile("s_waitcnt vmcnt(0)" ::: "memory");
            const unsigned og = xb_add(&bar[XB_TOP], 1u);
            const unsigned tg = og / nx;
            if (og + 1u == (tg + 1u) * nx) xb_add(&bar[XB_TOPGEN], 1u);
            else XB_SPIN(xb_ld(&bar[XB_TOPGEN]) == tg, bar);
            __builtin_amdgcn_fence(__ATOMIC_ACQUIRE, "agent");
            xb_add(&bar[XB_XGEN(b.x)], 1u);
            asm volatile("s_waitcnt vmcnt(0)" ::: "memory");
        } else {
            XB_SPIN(xb_ld(&bar[XB_XGEN(b.x)]) == gen, bar);
            __builtin_amdgcn_fence(__ATOMIC_ACQUIRE, "agent");
            asm volatile("s_waitcnt vmcnt(0)" ::: "memory");
        }
    }
    __syncthreads();
}


__device__ __forceinline__ void seam_arrive(unsigned* word, bool fence) {
    asm volatile("s_waitcnt vmcnt(0)" ::: "memory");
    __syncthreads();
    if (threadIdx.x == 0) {
        if (fence) { __builtin_amdgcn_fence(__ATOMIC_RELEASE, "agent"); asm volatile("s_waitcnt vmcnt(0)" ::: "memory"); }
        (void)__hip_atomic_fetch_add(word, 1u, __ATOMIC_RELAXED, __HIP_MEMORY_SCOPE_AGENT);
    }
}
__device__ __forceinline__ void seam_wait(unsigned* word, unsigned want, unsigned* tmo, unsigned code) {
    if (threadIdx.x < 64) { unsigned sp = 0;
        __builtin_amdgcn_fence(__ATOMIC_ACQUIRE, "agent");
        while ((unsigned)__builtin_amdgcn_readfirstlane(__hip_atomic_load(word, __ATOMIC_RELAXED, __HIP_MEMORY_SCOPE_AGENT)) < want) { __builtin_amdgcn_s_sleep(1);
            if (++sp > (1u << 20)) { if (threadIdx.x == 0) __hip_atomic_store(tmo, code, __ATOMIC_RELAXED, __HIP_MEMORY_SCOPE_AGENT); break; } }
        asm volatile("s_waitcnt vmcnt(0)" ::: "memory"); }
    __syncthreads();
}

__device__ __forceinline__ float wave_sum(float v) {
#pragma unroll
    for (int o = 1; o < 64; o <<= 1) v += __shfl_xor(v, o);
    return v;
}
__device__ __forceinline__ int w1_srccol(int n) {
    const int pn = n >> 8, c = n & 255, bj = c >> 7, wc = (c >> 5) & 3, nn = (c >> 4) & 1, fq = (c >> 2) & 3, j = c & 3;
    if (pn < 8) return (2 * bj + nn) * 512 + 64 * pn + 16 * wc + 4 * fq + j;
    if (bj == 0) return -1;
    return 2560 + 128 * (pn - 8) + 32 * wc + 8 * fq + 4 * nn + j;
}
struct TrItem { const float* W; const float* gs; bf16* WT; int ldw, n0, srccol, k0; };
__device__ __forceinline__ void tr_load(const TrItem& d, int lane, float (&v)[32]) {
#pragma unroll
    for (int i = 0; i < 32; ++i) v[i] = __builtin_nontemporal_load(d.W + (size_t)(d.k0 + 2 * i + (lane >> 5)) * d.ldw + d.srccol);
}
__device__ __forceinline__ void tr_finish(const TrItem& d, const float (&v)[32], LAS float* scr, int lane) {
    const int c = lane & 7;
    f32x4 g0 = {1.f, 1.f, 1.f, 1.f}, g1 = g0;
    if (d.gs) { g0 = *(const f32x4*)(d.gs + d.k0 + 8 * c); g1 = *(const f32x4*)(d.gs + d.k0 + 8 * c + 4); }
#pragma unroll
    for (int i = 0; i < 32; ++i) scr[(2 * i + (lane >> 5)) * 33 + (lane & 31)] = v[i];
    LDS_WAIT(); asm volatile("" ::: "memory");
#pragma unroll
    for (int j = 0; j < 4; ++j) { const int n = (lane >> 3) + 8 * j; const LAS float* s = scr + (8 * c) * 33 + n;
        v4u o; o.x = pk2(s[0 * 33] * g0[0], s[1 * 33] * g0[1]); o.y = pk2(s[2 * 33] * g0[2], s[3 * 33] * g0[3]); o.z = pk2(s[4 * 33] * g1[0], s[5 * 33] * g1[1]); o.w = pk2(s[6 * 33] * g1[2], s[7 * 33] * g1[3]);
        asm volatile("global_store_dwordx4 %0, %1, off sc1\n\ts_nop 1" :: "v"(d.WT + (size_t)(d.n0 + n) * D + d.k0 + 8 * c), "v"(o) : "memory"); }
    LDS_WAIT(); asm volatile("" ::: "memory");
}
__device__ __forceinline__ void p0_pool_item(const float* win, const float* gpre, const float* wpool, bf16* W1T, LAS float* scr, int item, int lane) {
    const int db = item & 3, g = (item >> 2) & 3, kb = item >> 4;
    const int k0 = 32 * kb, d0 = 32 * db, i = lane & 31, h = lane >> 5;
    float b[64];
#pragma unroll
    for (int s = 0; s < 64; ++s) b[s] = wpool[(size_t)(g * 128 + 2 * s + h) * 128 + d0 + i];
#pragma unroll
    for (int r = 0; r < 16; ++r) { const int kk = 2 * r + h; const f32x4 v = *(const f32x4*)(win + (size_t)(k0 + kk) * NIN + 2048 + 128 * g + 4 * i); const float gs = gpre[k0 + kk];
        LAS float* d = scr + kk * 129 + 4 * i; d[0] = v[0] * gs; d[1] = v[1] * gs; d[2] = v[2] * gs; d[3] = v[3] * gs; }
    LDS_WAIT(); asm volatile("" ::: "memory");
    f32x16 acc;
#pragma unroll
    for (int r = 0; r < 16; ++r) acc[r] = 0.f;
#pragma unroll
    for (int s = 0; s < 64; ++s) { const float a = scr[i * 129 + 2 * s + h]; acc = __builtin_amdgcn_mfma_f32_32x32x2f32(a, b[s], acc, 0, 0, 0); }
    const int d = d0 + i, n = 256 * (8 + g) + 32 * (d >> 5) + 16 * ((d >> 2) & 1) + 4 * ((d >> 3) & 3) + (d & 3);
#pragma unroll
    for (int q = 0; q < 4; ++q) { v2u o; o.x = pk2(acc[4 * q + 0], acc[4 * q + 1]); o.y = pk2(acc[4 * q + 2], acc[4 * q + 3]); __hip_atomic_store((unsigned long long*)(W1T + (size_t)n * D + k0 + 8 * q + 4 * h), ((unsigned long long)o.y << 32) | o.x, __ATOMIC_RELAXED, __HIP_MEMORY_SCOPE_AGENT); }
    LDS_WAIT(); asm volatile("" ::: "memory");
}

struct Args { const float* in[9]; float* out; unsigned char* ws; int ph_lo, ph_hi; };

__device__ __forceinline__ void p0_prologue(const Args& a, LAS unsigned char* lds, int gw, int NGW, int wave, int lane) {
    LAS float* scr = (LAS float*)(lds + wave * SCR_STRIDE);
    const float* x = a.in[0]; const float* pre_norm = a.in[1]; const float* w_in = a.in[2]; const float* w_pool = a.in[5]; const float* w_out = a.in[7];
    bf16* W1T = (bf16*)(a.ws + WS_W1T); bf16* W2T = (bf16*)(a.ws + WS_W2T); bf16* XB = (bf16*)(a.ws + WS_XB); float* SSQ = (float*)(a.ws + WS_SSQ);
    constexpr int I_POOL = DEPTH * 512, I_W1 = DEPTH * 80 * 16, I_W2 = DEPTH * 32 * 16, I_TR = I_W1 + I_W2;
    { unsigned long long* xs = (unsigned long long*)(a.ws + WS_XSLOT);
      for (int i = gw * 64 + lane; i < DEPTH * M * 4; i += NGW * 64) __hip_atomic_store(xs + i, 0ull, __ATOMIC_RELAXED, __HIP_MEMORY_SCOPE_AGENT);
      unsigned long long* hz = (unsigned long long*)(a.ws + WS_HGA);
      for (int i = gw * 64 + lane; i < DEPTH * 8 * 64 * 128; i += NGW * 64) __hip_atomic_store(hz + i, 0ull, __ATOMIC_RELAXED, __HIP_MEMORY_SCOPE_AGENT); }
#define P0_TR_DESC(d, r_) do { int r = (r_); \
        if (r < I_W1) { const int l = r / 1280, q = r % 1280, nbi = q % 80, kb = q / 80;     \
            const int n0 = nbi < 64 ? 32 * nbi : 256 * (8 + ((nbi - 64) >> 2)) + 128 + 32 * ((nbi - 64) & 3); \
            d.W = w_in + (size_t)l * D * NIN; d.gs = pre_norm + l * D; d.WT = W1T + (size_t)l * NIN * D; d.ldw = NIN; d.n0 = n0; d.srccol = w1_srccol(n0 + (lane & 31)); d.k0 = 64 * kb; } \
        else { r -= I_W1; const int l = r >> 9, q = r & 511, nb = q & 31, kb = q >> 5; \
            d.W = w_out + (size_t)l * D * D; d.gs = nullptr; d.WT = W2T + (size_t)l * D * D; d.ldw = D; d.n0 = 32 * nb; d.srccol = 32 * nb + (lane & 31); d.k0 = 64 * kb; } } while (0)
    if (NGW == 2048) {
        if (gw < I_POOL) {
            TrItem d; float v[32]; const bool has = gw < I_TR - 3 * 1024;
            if (has) { P0_TR_DESC(d, 3 * 1024 + gw); tr_load(d, lane, v); }
            { const int l = gw >> 9; p0_pool_item(w_in + (size_t)l * D * NIN, pre_norm + l * D, w_pool + (size_t)l * 4 * 128 * 128, W1T + (size_t)l * NIN * D, scr, gw & 511, lane); }
            if (has) tr_finish(d, v, scr, lane);
        } else {
            TrItem d0, d1, d2; float v0[32], v1[32], v2[32]; const int t0 = (gw - 1024) * 3;
            P0_TR_DESC(d0, t0); tr_load(d0, lane, v0); P0_TR_DESC(d1, t0 + 1); tr_load(d1, lane, v1); P0_TR_DESC(d2, t0 + 2); tr_load(d2, lane, v2);
            tr_finish(d0, v0, scr, lane); tr_finish(d1, v1, scr, lane); tr_finish(d2, v2, scr, lane);
        }
    } else {
        for (int it = gw; it < I_POOL + I_TR; it += NGW) {
            if (it < I_POOL) { const int l = it >> 9; p0_pool_item(w_in + (size_t)l * D * NIN, pre_norm + l * D, w_pool + (size_t)l * 4 * 128 * 128, W1T + (size_t)l * NIN * D, scr, it & 511, lane); }
            else { TrItem d; float v[32]; P0_TR_DESC(d, it - I_POOL); tr_load(d, lane, v); tr_finish(d, v, scr, lane); }
        }
    }
#undef P0_TR_DESC
    const int xstep = (NGW == 2048) ? 1 : NGW, xc = gw >> 3;
    const int xfirst = (NGW == 2048) ? (8 * (xc & 7) + ((xc >> 3) & 7)) * 256 + (xc >> 6) * 64 + (gw & 7) * 8 : gw, xend = (NGW == 2048) ? xfirst + 8 : M;
    for (int r0 = xfirst; r0 < xend; r0 += 4 * xstep) {
        f32x4 v[4][4];
#pragma unroll
        for (int q = 0; q < 4; ++q) { const f32x4* xr = (const f32x4*)(x + (size_t)(r0 + q * xstep) * D) + lane;
#pragma unroll
            for (int j = 0; j < 4; ++j) v[q][j] = (r0 + q * xstep < M) ? __builtin_nontemporal_load(xr + 64 * j) : (f32x4){0.f, 0.f, 0.f, 0.f}; }
#pragma unroll
        for (int q = 0; q < 4; ++q) { const int r = r0 + q * xstep; if (r >= M) break; float s = 0.f;
#pragma unroll
            for (int j = 0; j < 4; ++j) s += (v[q][j][0] * v[q][j][0] + v[q][j][1] * v[q][j][1]) + (v[q][j][2] * v[q][j][2] + v[q][j][3] * v[q][j][3]);
            s = wave_sum(s);
            if (lane == 0) *(f32x4*)(SSQ + (size_t)r * 4) = (f32x4){s, 0.f, 0.f, 0.f};
            v2u* o8 = (v2u*)(XB + (size_t)r * D) + lane;
#pragma unroll
            for (int j = 0; j < 4; ++j) { v2u o; o.x = pk2(v[q][j][0], v[q][j][1]); o.y = pk2(v[q][j][2], v[q][j][3]); o8[64 * j] = o; } }
    }
}

__global__ void __launch_bounds__(NWAVES * 64, 2) mk_fwd(Args args) {
    extern __shared__ __attribute__((aligned(16))) unsigned char lds_raw[];
    LAS unsigned char* lds = (LAS unsigned char*)lds_raw;
    volatile LAS unsigned* MISC = (volatile LAS unsigned*)(lds + MISC_OFF);
    const int tid = threadIdx.x, lane = tid & 63, wave = __builtin_amdgcn_readfirstlane(tid >> 6);
    const int G = gridDim.x;
    unsigned char* ws = args.ws;
    unsigned* ctl = (unsigned*)(ws + WS_CTL);
    if (tid < 64) MISC[tid] = 0u;
    __syncthreads();
    if (tid == 0) __hip_atomic_store(ctl + CW_XCC + blockIdx.x, xb_xcc_id() + 1u, __ATOMIC_RELAXED, __HIP_MEMORY_SCOPE_AGENT);
    XcdBarrier bar; bar.bar = ctl + CW_BAR; bar.x = 0; bar.st = nullptr;
    if (N_LAUNCHES == 1) bar = xcd_barrier_post(ctl + CW_BAR, MISC + 8);
#define GRID_BAR() do { if (N_LAUNCHES == 1) xcd_barrier(bar); } while (0)
    const int lo = args.ph_lo, hi = args.ph_hi;
#define IN(k) (lo <= (k) && (k) < hi)
    bf16* W1T = (bf16*)(ws + WS_W1T); bf16* W2T = (bf16*)(ws + WS_W2T); bf16* XB = (bf16*)(ws + WS_XB); bf16* Y = (bf16*)(ws + WS_Y);
    float* SSQ = (float*)(ws + WS_SSQ);

#define PHASE_P0() do { if (IN(0)) { PROF_START(25, lds, wave); p0_prologue(args, lds, blockIdx.x * NWAVES + wave, G * NWAVES, wave, lane); PROF_STOP(25, lds, wave); PROF_START(24, lds, wave); P0_PARTNERS(); if (N_LAUNCHES == 1) { if (quad) xcd_barrier(bar, false, MISC[17] != 0u); else xcd_barrier(bar); } PROF_STOP(24, lds, wave); } } while (0)
    int my_pm; { pg8::StaticOrder S; S.init(M, NIN, G, (int)blockIdx.x); pg8::Unit u0, u1; S.next(0, u0); my_pm = u0.pm; bool same = true; for (int i = 1; S.next(i, u1); ++i) same &= (u1.pm == u0.pm);
                 pg8::StaticOrder S2; S2.init(M, D, G, (int)blockIdx.x); S2.next(0, u1); same &= (u1.pm == u0.pm) && G == 256; if (!same) my_pm = -1; }
    const bool quad = (MK_QUAD != 0) && N_LAUNCHES == 1 && my_pm >= 0;
    unsigned* seamw = ctl + CW_CNT + (my_pm < 0 ? 0 : my_pm) * 16;
#define SEAM_DONE(s_) do { PROF_START(21, lds, wave); if (quad) seam_arrive(seamw + (s_) * 1024, MISC[17] != 0u); else GRID_BAR(); PROF_STOP(21, lds, wave); } while (0)
#define SEAM_WAIT(s_) do { PROF_START(20, lds, wave); if (quad) seam_wait(seamw + (s_) * 1024, 4u, ctl + CW_TMO, 0x600u + (s_)); PROF_STOP(20, lds, wave); } while (0)
#define PHASE_G1(l) do { if (IN(1 + 2 * (l))) { \
            if ((l) > 0) SEAM_WAIT(1); \
            pg8::Gemm g{XB, W1T + (size_t)(l) * NIN * D, M, NIN, D}; pg8::StaticOrder S; S.init(M, NIN, G, (int)blockIdx.x); \
            pg8::EpiMix E{Y, SSQ, args.in[3] + (size_t)(l) * 3 * 512, args.in[4] + (size_t)(l) * 512, args.in[6] + (size_t)(l) * 512, \
                          (float*)(ws + WS_HALO) + (size_t)(l) * 768 * pg8::HALO_TILE, ctl + CW_FLAG + (l) * 768 * 16, ctl + CW_TMO, (unsigned)((l) + 1), (unsigned long long*)(ws + WS_HGA) + (size_t)(l) * 8 * 64 * 128}; \
            pg8::gemm_phase<pg8::EpiMix, pg8::StaticOrder, true, true>(lds, g, S, E); \
            SEAM_DONE(2 * (l)); } } while (0)
#define PHASE_G2_0() do { if (IN(2)) { \
        SEAM_WAIT(0); \
        pg8::Gemm g{Y, W2T, M, D, D}; pg8::StaticOrder S; S.init(M, D, G, (int)blockIdx.x); \
        pg8::EpiRms<0> E{XB, nullptr, XB, SSQ, args.in[8], (unsigned long long*)(ws + WS_XSLOT), ctl + CW_TMO, 1u}; \
        pg8::gemm_phase<pg8::EpiRms<0>, pg8::StaticOrder, false, true>(lds, g, S, E); SEAM_DONE(1); } } while (0)
#define PHASE_G2_1(last) do { if (IN(4)) { \
        SEAM_WAIT(2); \
        pg8::Gemm g{Y, W2T + (size_t)D * D, M, D, D}; pg8::StaticOrder S; S.init(M, D, G, (int)blockIdx.x); \
        pg8::EpiRms<1> E{XB, args.out, nullptr, nullptr, args.in[8] + D, (unsigned long long*)(ws + WS_XSLOT) + (size_t)M * 4, ctl + CW_TMO, 2u}; \
        pg8::gemm_phase<pg8::EpiRms<1>, pg8::StaticOrder, false, true>(lds, g, S, E); if (!(last)) GRID_BAR(); } } while (0)
#define P0_PARTNERS() do { if (quad && tid == 0) { \
        const unsigned c0 = (blockIdx.x & 7u) + 8u * ((blockIdx.x >> 3) & 7u); const unsigned mine = xb_xcc_id() + 1u; unsigned diff = 0u; \
        for (unsigned k = 0; k < 4; ++k) { unsigned v = 0u, sp = 0u; \
            while ((v = __hip_atomic_load(ctl + CW_XCC + c0 + 64u * k, __ATOMIC_RELAXED, __HIP_MEMORY_SCOPE_AGENT)) == 0u && ++sp < (1u << 16)) __builtin_amdgcn_s_sleep(1); \
            diff |= (v != mine) ? 1u : 0u; } \
        MISC[17] = diff; } \
    __syncthreads(); } while (0)
    PHASE_P0();
    PHASE_G1(0);
    PHASE_G2_0();
    PHASE_G1(1);
    PHASE_G2_1(true);
#undef PHASE_P0
#undef P0_PARTNERS
#undef SEAM_DONE
#undef SEAM_WAIT
#undef PHASE_G2_0
#undef PHASE_G2_1
    if (PROF_ID != 0 && blockIdx.x == PROF_BLOCK && tid == 0) {
        const unsigned long long t0 = __builtin_amdgcn_s_memrealtime();
#ifdef PROF_CLK
        const unsigned long long want = (unsigned long long)MISC[20] / 10u;
#else
        const unsigned long long want = (unsigned long long)MISC[20] * PROF_SCALE;
#endif

        while (__builtin_amdgcn_s_memrealtime() - t0 < want) __builtin_amdgcn_s_sleep(8);
    }
#undef PHASE_G1
#undef IN
#undef GRID_BAR
}

extern "C" void kernel_launch(void* const* d_in, const int* in_sizes, int n_in, void* d_out, int out_size, void* d_ws, size_t ws_size, hipStream_t stream) {
    static int grid = 0;
    if (grid == 0) {
        if (n_in != 9 || in_sizes[0] != M * D || out_size != M * D || ws_size < WS_END) { fprintf(stderr, "kernel_launch: unexpected shapes (n_in %d, in0 %d, out %d, ws %zu); nothing launched\n", n_in, n_in > 0 ? in_sizes[0] : -1, out_size, ws_size); grid = -1; return; }
        int dev = 0, cus = 0, per_cu = 0;
        if (hipGetDevice(&dev) != hipSuccess || hipDeviceGetAttribute(&cus, hipDeviceAttributeMultiprocessorCount, dev) != hipSuccess) { grid = -1; return; }
        if (hipFuncSetAttribute((const void*)mk_fwd, hipFuncAttributeMaxDynamicSharedMemorySize, LDS_BYTES) != hipSuccess) { fprintf(stderr, "kernel_launch: hipFuncSetAttribute failed\n"); grid = -1; return; }
        if (hipOccupancyMaxActiveBlocksPerMultiprocessor(&per_cu, (const void*)mk_fwd, NWAVES * 64, LDS_BYTES) != hipSuccess || per_cu < 1) fprintf(stderr, "kernel_launch: occupancy query reports %d blocks per CU\n", per_cu);
        (void)hipGetLastError();
        grid = cus;
        if (grid != 256) fprintf(stderr, "kernel_launch: %d CUs; the fused GEMM2 epilogue expects 256 workgroups\n", grid);
    }
    if (grid < 0) return;
    (void)hipMemsetAsync((char*)d_ws + WS_CTL, 0, CTL_ZERO_BYTES, stream);
    Args a{};
    for (int i = 0; i < 9; ++i) a.in[i] = (const float*)d_in[i];
    a.out = (float*)d_out; a.ws = (unsigned char*)d_ws;
    for (int li = 0; li < N_LAUNCHES; ++li) {
        a.ph_lo = (N_LAUNCHES == 1) ? 0 : li; a.ph_hi = (N_LAUNCHES == 1) ? N_PHASES : li + 1;
        hipLaunchKernelGGL(mk_fwd, dim3(grid), dim3(NWAVES * 64), LDS_BYTES, stream, a);
    }
}
```

```cpp
#include <hip/hip_runtime.h>
#include <cstdio>
#include <cstdint>
#ifndef MK_QUAD
#define MK_QUAD 1
#endif
namespace pg8 {
#define PG8_LAS __attribute__((address_space(3)))
typedef unsigned short bf16_t;
typedef short bf16x8 __attribute__((ext_vector_type(8)));
typedef float f32x4 __attribute__((ext_vector_type(4)));
typedef unsigned u32x4 __attribute__((ext_vector_type(4)));
constexpr int BM = 256, BK = 64, HALF = 128, HTB = HALF * BK * 2  , STAGE_BYTES = 8 * HTB, NXCD = 8, WGM = 8;

__host__ __device__ __forceinline__ int lds_byte(int r, int c) { const int st = (r >> 4) * 2 + (c >> 5), rr = r & 15, cc = c & 31, ob = rr * 64 + cc * 2; return st * 1024 + (ob ^ (((ob >> 9) & 1) << 5)); }
__host__ __device__ __forceinline__ void stage_rc(int b, int& R, int& C) { const int st = b / 1024, sb = b % 1024, swz = sb ^ (((sb >> 9) & 1) << 5); R = (st >> 1) * 16 + swz / 64; C = (st & 1) * 32 + (swz % 64) / 2; }
__host__ __device__ __forceinline__ int perm32(int rho) { const int n = rho >> 4, i = rho & 15; return 8 * (i >> 2) + 4 * n + (i & 3); }

struct Unit { int pm, pn; };
struct Gemm { const bf16_t* A; const bf16_t* Bt; int M, N, K; };

struct StaticOrder {
    int nM, nN, nwg, G, c;
    __host__ __device__ __forceinline__ void init(int M, int N, int G_, int c_) { nM = M / BM; nN = N / BM; nwg = nM * nN; G = G_; c = c_; }
    __host__ __device__ __forceinline__ bool next(int i, Unit& u) const {
        const long L = (long)i * G + c; if (L >= nwg) return false;
        int wgid = (int)L; { const int q = nwg / NXCD, r = nwg % NXCD, xcd = wgid % NXCD, off = wgid / NXCD; wgid = (xcd < r ? xcd * (q + 1) : r * (q + 1) + (xcd - r) * q) + off; }
        const int nig = WGM * nN, gid = wgid / nig, fm = gid * WGM, gsz = (nM - fm) < WGM ? (nM - fm) : WGM;
        u.pm = fm + ((wgid % nig) % gsz); u.pn = (wgid % nig) / gsz; return true;
    }
    __device__ __forceinline__ void a_ready(const Unit&) const {}
    __device__ __forceinline__ void done(const Unit&) const {}
};


typedef unsigned u32x2 __attribute__((ext_vector_type(2)));
__device__ __forceinline__ unsigned cvt_pk_bf16(float lo, float hi) { unsigned r; asm volatile("v_cvt_pk_bf16_f32 %0, %1, %2" : "=v"(r) : "v"(lo), "v"(hi)); return r; }
__device__ __forceinline__ float silu_f(float z) { return z * __builtin_amdgcn_rcpf(1.0f + __expf(-z)); }
__device__ __forceinline__ f32x4 mul_silu4(const f32x4& x, const f32x4& z) {
    const f32x4 t = z * (-1.44269504089f);
    f32x4 e; e[0] = __builtin_amdgcn_exp2f(t[0]); e[1] = __builtin_amdgcn_exp2f(t[1]); e[2] = __builtin_amdgcn_exp2f(t[2]); e[3] = __builtin_amdgcn_exp2f(t[3]);
    const f32x4 d = e + 1.0f;
    f32x4 r; r[0] = __builtin_amdgcn_rcpf(d[0]); r[1] = __builtin_amdgcn_rcpf(d[1]); r[2] = __builtin_amdgcn_rcpf(d[2]); r[3] = __builtin_amdgcn_rcpf(d[3]);
    return (x * z) * r;
}
template <int K> __device__ __forceinline__ float shl_prev(float cur, float prev) {
    const int t = __builtin_amdgcn_update_dpp(0, __float_as_int(prev), 0x120 + K, 0xf, 0xf, false);
    return __int_as_float(__builtin_amdgcn_update_dpp(t, __float_as_int(cur), 0x110 + K, 0xf, 0xf, false));
}
template <int K> __device__ __forceinline__ float shl_zero(float cur) { return __int_as_float(__builtin_amdgcn_update_dpp(0, __float_as_int(cur), 0x110 + K, 0xf, 0xf, true)); }

constexpr int HBS = 132;
constexpr int HB_BYTES = 3 * 16 * HBS * 4;
constexpr int HALO_TILE = 16 * 128;
constexpr int EPI_HB_OFF = STAGE_BYTES, EPI_MISC_OFF = EPI_HB_OFF + 25600, EPI_INV_OFF = EPI_MISC_OFF + 256, EPI_LDS_END = EPI_INV_OFF + 1024;
static_assert(HB_BYTES <= 25600, "halo images");

#ifndef PROF_ID
#define PROF_ID 0
#endif
#ifndef PROF_BLOCK
#define PROF_BLOCK 9
#endif
#ifndef PROF_WAVE
#define PROF_WAVE 0
#endif
#define PROF_SCALE 20u
#ifdef PROF_CLK
#define PROF_NOW() ((unsigned)__builtin_amdgcn_s_memtime())
#else
#define PROF_NOW() ((unsigned)__builtin_amdgcn_s_memrealtime())
#endif
#define PROF_START(n, lds_, wid_) do { if (PROF_ID == (n) && blockIdx.x == PROF_BLOCK && (wid_) == PROF_WAVE) { const unsigned t_ = PROF_NOW(); \
        if ((threadIdx.x & 63) == 0) ((volatile PG8_LAS unsigned*)((lds_) + pg8::EPI_MISC_OFF))[22] = t_; } } while (0)
#define PROF_STOP(n, lds_, wid_) do { if (PROF_ID == (n) && blockIdx.x == PROF_BLOCK && (wid_) == PROF_WAVE) { const unsigned t_ = PROF_NOW(); \
        if ((threadIdx.x & 63) == 0) { volatile PG8_LAS unsigned* m_ = (volatile PG8_LAS unsigned*)((lds_) + pg8::EPI_MISC_OFF); m_[20] = m_[20] + (t_ - m_[22]); } } } while (0)

__device__ __forceinline__ u32x2 mixA_block(const f32x4& gate, const f32x4& chv, const f32x4& prev, const f32x4& w0, const f32x4& w1, const f32x4& w2, const f32x4& cb) {
    f32x4 c1, c2;
#pragma unroll
    for (int j = 0; j < 4; ++j) { c1[j] = shl_prev<1>(chv[j], prev[j]); c2[j] = shl_prev<2>(chv[j], prev[j]); }
    const f32x4 o = gate * (w0 * c2 + w1 * c1 + w2 * chv + cb);
    u32x2 w; w.x = cvt_pk_bf16(o[0], o[1]); w.y = cvt_pk_bf16(o[2], o[3]); return w;
}
__device__ __forceinline__ u32x4 mixB_block(const f32x4 (&cu)[2], const f32x4 (&pu)[2], const f32x4 (&sg)[2], float rc, int w) {
    float o[8];
#pragma unroll
    for (int e = 0; e < 8; ++e) {
        const float uv = cu[e >> 2][e & 3], up = pu[e >> 2][e & 3];
        float s = uv + shl_prev<1>(uv, up);
        if (w >= 4) { float sp = up + shl_zero<1>(up); s += shl_prev<2>(s, sp);
            if (w >= 8) { sp += shl_zero<2>(sp); s += shl_prev<4>(s, sp);
                if (w >= 16) { sp += shl_zero<4>(sp); s += shl_prev<8>(s, sp); } } }
        o[e] = (s * rc - uv) * sg[e >> 2][e & 3];
    }
    u32x4 wv; wv.x = cvt_pk_bf16(o[0], o[1]); wv.y = cvt_pk_bf16(o[2], o[3]); wv.z = cvt_pk_bf16(o[4], o[5]); wv.w = cvt_pk_bf16(o[6], o[7]); return wv;
}
template <int K> __device__ __forceinline__ float shl_zero_fwd(float cur) { return __int_as_float(__builtin_amdgcn_update_dpp(0, __float_as_int(cur), 0x100 + K, 0xf, 0xf, true)); }
template <int K> __device__ __forceinline__ float row_ror(float cur) { return __int_as_float(__builtin_amdgcn_update_dpp(0, __float_as_int(cur), 0x120 + K, 0xf, 0xf, false)); }
template <int W> __device__ __forceinline__ void lead_sums(const f32x4 (&p)[2], f32x4 (&q)[2]) {
#pragma unroll
    for (int e = 0; e < 8; ++e) { float t = p[e >> 2][e & 3]; t += shl_zero_fwd<1>(t); if (W >= 4) t += shl_zero_fwd<2>(t); if (W >= 8) t += shl_zero_fwd<4>(t); if (W >= 16) t += shl_zero_fwd<8>(t); q[e >> 2][e & 3] = t; }
}
template <int W> __device__ __forceinline__ u32x4 mixB_blockT(const f32x4 (&cu)[2], const f32x4 (&pq)[2], const f32x4 (&sg)[2], float rc, float maskf) {
    float o[8];
#pragma unroll
    for (int e = 0; e < 8; ++e) {
        const float uv = cu[e >> 2][e & 3];
        float s = uv + shl_zero<1>(uv); if (W >= 4) s += shl_zero<2>(s); if (W >= 8) s += shl_zero<4>(s); if (W >= 16) s += shl_zero<8>(s);
        s = fmaf(row_ror<W - 1>(pq[e >> 2][e & 3]), maskf, s);
        o[e] = (s * rc - uv) * sg[e >> 2][e & 3];
    }
    u32x4 wv; wv.x = cvt_pk_bf16(o[0], o[1]); wv.y = cvt_pk_bf16(o[2], o[3]); wv.z = cvt_pk_bf16(o[4], o[5]); wv.w = cvt_pk_bf16(o[6], o[7]); return wv;
}
__device__ __forceinline__ void st_sc1_f32x4(float* p, const f32x4& v) {
    __hip_atomic_store((unsigned long long*)p, ((unsigned long long)__float_as_uint(v[1]) << 32) | __float_as_uint(v[0]), __ATOMIC_RELAXED, __HIP_MEMORY_SCOPE_AGENT);
    __hip_atomic_store((unsigned long long*)p + 1, ((unsigned long long)__float_as_uint(v[3]) << 32) | __float_as_uint(v[2]), __ATOMIC_RELAXED, __HIP_MEMORY_SCOPE_AGENT);
}
__device__ __forceinline__ void st_pay_u32x2(void* p, const u32x2& v) {
    *(u32x2*)p = v;
}
__device__ __forceinline__ void st_pay_u32x4(void* p, const u32x4& v) {
    *(u32x4*)p = v;
}
__device__ __forceinline__ void st_pay_f32(float* p, float v) {
    *p = v;
}
__device__ __forceinline__ f32x4 ld_sc1_f32x4(const float* p) {
    const unsigned long long a = __hip_atomic_load((unsigned long long*)p, __ATOMIC_RELAXED, __HIP_MEMORY_SCOPE_AGENT), b = __hip_atomic_load((unsigned long long*)p + 1, __ATOMIC_RELAXED, __HIP_MEMORY_SCOPE_AGENT);
    return (f32x4){__uint_as_float((unsigned)a), __uint_as_float((unsigned)(a >> 32)), __uint_as_float((unsigned)b), __uint_as_float((unsigned)(b >> 32))};
}

struct EpiMix {
    static constexpr bool PERM = false, AFTER_DRAIN = false;
    bf16_t* Y; const float* ssqp; const float* convw; const float* convb; const float* pscale;
    float* halo; unsigned* flags; unsigned* tmo; unsigned epoch;
    unsigned long long* hga;
    __device__ __forceinline__ void sweepA(const unsigned long long* g, bool active, f32x4& v, const Unit& u, int lane) const {
        for (unsigned sp = 0;;) { bool ok = true;
            if (active) {
#pragma unroll
                for (int k = 0; k < 4; ++k) { const unsigned long long x = __hip_atomic_load((unsigned long long*)g + k, __ATOMIC_RELAXED, __HIP_MEMORY_SCOPE_AGENT); v[k] = __uint_as_float((unsigned)x); ok &= ((unsigned)(x >> 32) == epoch); } }
            if (__all(ok)) return;
            __builtin_amdgcn_s_sleep(2);
            if (++sp > (1u << 20)) { if (lane == 0) __hip_atomic_store(tmo, 0x500u | (unsigned)u.pn, __ATOMIC_RELAXED, __HIP_MEMORY_SCOPE_AGENT); return; } }
    }
    __device__ __forceinline__ void wait_flag(const Unit& u, int lane) const {
        unsigned sp = 0; unsigned* fl = flags + ((u.pm - 1) * 12 + u.pn) * 16; const unsigned want = 4u;
        while ((unsigned)__builtin_amdgcn_readfirstlane(__hip_atomic_load(fl, __ATOMIC_RELAXED, __HIP_MEMORY_SCOPE_AGENT)) < want) { __builtin_amdgcn_s_sleep(1);
            if (++sp > (1u << 20)) { if (lane == 0) __hip_atomic_store(tmo, 0x500u | (unsigned)u.pn, __ATOMIC_RELAXED, __HIP_MEMORY_SCOPE_AGENT); break; } }
    }
    __device__ __forceinline__ u32x4 b_block(int g, const f32x4 (&cu)[2], const f32x4 (&pu)[2], const f32x4 (&sg)[2], float rc, int fr) const {
        f32x4 q[2]; u32x4 r;
        if (g == 0) { lead_sums<2>(pu, q); r = mixB_blockT<2>(cu, q, sg, rc, fr < 1 ? 1.0f : 0.0f); }
        else if (g == 1) { lead_sums<4>(pu, q); r = mixB_blockT<4>(cu, q, sg, rc, fr < 3 ? 1.0f : 0.0f); }
        else if (g == 2) { lead_sums<8>(pu, q); r = mixB_blockT<8>(cu, q, sg, rc, fr < 7 ? 1.0f : 0.0f); }
        else { lead_sums<16>(pu, q); r = mixB_blockT<16>(cu, q, sg, rc, fr < 15 ? 1.0f : 0.0f); }
        return r;
    }
    __device__ __forceinline__ void operator()(f32x4 (&acc)[2][2][4][2], const Unit& u, int wr, int wc, int fr, int fq, PG8_LAS unsigned char* lds, int wid, int lane) const {
        asm volatile("" : "+v"(fr), "+v"(fq), "+v"(lane));
        PROF_START(2, lds, wid);
        PG8_LAS float* HB = (PG8_LAS float*)(lds + EPI_HB_OFF);
        PG8_LAS float* INV = (PG8_LAS float*)(lds + EPI_INV_OFF);
        volatile PG8_LAS unsigned* KEY = (volatile PG8_LAS unsigned*)(lds + EPI_MISC_OFF + 64);
        const unsigned key = (epoch << 16) | (unsigned)u.pm;
        if (KEY[0] != key) {
            int t = threadIdx.x; asm volatile("" : "+v"(t));
            if (t < 256) { const f32x4 p = *(const f32x4*)(ssqp + (size_t)(u.pm * BM + t) * 4); INV[t] = rsqrtf(((p[0] + p[1]) + (p[2] + p[3])) * (1.0f / 1024.0f) + 1e-6f); }
            asm volatile("s_waitcnt lgkmcnt(0)" ::: "memory"); __builtin_amdgcn_s_barrier(); asm volatile("" ::: "memory");
            if (t == 0) KEY[0] = key;
        }
        const int rl = wr * 64 + fr, row0 = u.pm * BM + rl;
        const bool need = (u.pm & 31) != 0;
        float* halo_out = halo + (size_t)(u.pn * 64 + u.pm) * HALO_TILE;
        const float* halo_in = halo_out - HALO_TILE;
        unsigned* myflag = flags + (u.pm * 12 + u.pn) * 16;
        float inv[2][4];
#pragma unroll
        for (int ai = 0; ai < 2; ++ai)
#pragma unroll
            for (int m = 0; m < 4; ++m) inv[ai][m] = INV[rl + ai * HALF + m * 16];
        const f32x4 zero = {0.f, 0.f, 0.f, 0.f};
        if (u.pn < 8) {
            const int chl = 16 * wc + 4 * fq, chg = 64 * u.pn + chl;
            const f32x4 w0 = *(const f32x4*)(convw + chg), w1 = *(const f32x4*)(convw + 512 + chg), w2 = *(const f32x4*)(convw + 1024 + chg), cb = *(const f32x4*)(convb + chg);
            unsigned long long* ga = hga + (size_t)(u.pn * 64 + u.pm) * 128 + (fr >= 14 ? (fr - 14) * 64 + chl : 0);
            if (wr == 1 && fr >= 14) { const float s = inv[1][3]; const f32x4 t = (acc[1][0][3][1] * s) * (acc[1][1][3][0] * s);
#pragma unroll
                for (int j = 0; j < 4; ++j) __hip_atomic_store(ga + j, ((unsigned long long)epoch << 32) | __float_as_uint(t[j]), __ATOMIC_RELAXED, __HIP_MEMORY_SCOPE_AGENT); }
#pragma unroll
            for (int ai = 0; ai < 2; ++ai)
#pragma unroll
                for (int m = 0; m < 4; ++m) { const float s = inv[ai][m]; const f32x4 b = acc[ai][0][m][0] * s, c = acc[ai][0][m][1] * s, h = acc[ai][1][m][0] * s, z = acc[ai][1][m][1] * s; f32x4 g;
#pragma unroll
                    for (int j = 0; j < 4; ++j) g[j] = 0.f;
                    acc[ai][0][m][0] = mul_silu4(b, z); acc[ai][0][m][1] = c * h; }
            PROF_STOP(2, lds, wid); PROF_START(3, lds, wid);
            if (fr >= 14) {
                *(PG8_LAS f32x4*)(HB + (wr * 16 + fr) * HBS + chl) = acc[0][0][3][1];
                if (wr == 0) *(PG8_LAS f32x4*)(HB + (32 + fr) * HBS + chl) = acc[1][0][3][1];
            }
            asm volatile("s_waitcnt lgkmcnt(0)" ::: "memory"); __builtin_amdgcn_s_barrier(); asm volatile("" ::: "memory");
            PROF_STOP(3, lds, wid); PROF_START(4, lds, wid);
            u32x2 o[2][4];
            { const f32x4 pv = (fr >= 14) ? *(const PG8_LAS f32x4*)(HB + ((1 + wr) * 16 + fr) * HBS + chl) : zero;
              o[1][0] = mixA_block(acc[1][0][0][0], acc[1][0][0][1], pv, w0, w1, w2, cb); }
#pragma unroll
            for (int m = 1; m < 4; ++m) o[1][m] = mixA_block(acc[1][0][m][0], acc[1][0][m][1], acc[1][0][m - 1][1], w0, w1, w2, cb);
            PROF_STOP(4, lds, wid); PROF_START(5, lds, wid);
            f32x4 pvg = zero;
            if (wr == 1) { if (fr >= 14) pvg = *(const PG8_LAS f32x4*)(HB + fr * HBS + chl); }
            else if (need) sweepA(ga - 128, fr >= 14, pvg, u, lane);
            PROF_STOP(5, lds, wid); PROF_START(6, lds, wid);
#pragma unroll
            for (int m = 1; m < 4; ++m) o[0][m] = mixA_block(acc[0][0][m][0], acc[0][0][m][1], acc[0][0][m - 1][1], w0, w1, w2, cb);
            o[0][0] = mixA_block(acc[0][0][0][0], acc[0][0][0][1], pvg, w0, w1, w2, cb);
            PROF_STOP(6, lds, wid); PROF_START(7, lds, wid);
            bf16_t* yp = Y + (size_t)row0 * 1024 + chg;
#pragma unroll
            for (int ai = 0; ai < 2; ++ai)
#pragma unroll
                for (int m = 0; m < 4; ++m) st_pay_u32x2(yp + (size_t)(ai * HALF + 16 * m) * 1024, o[ai][m]);
            PROF_STOP(7, lds, wid);
        } else {
            const int g = u.pn - 8, dl = 32 * wc + 8 * fq;
            const f32x4 sc0 = *(const f32x4*)(pscale + 128 * g + dl), sc1 = *(const f32x4*)(pscale + 128 * g + dl + 4);
            if (wr == 1) { const float s = inv[1][3]; st_sc1_f32x4(halo_out + fr * 128 + dl, acc[1][0][3][0] * s); st_sc1_f32x4(halo_out + fr * 128 + dl + 4, acc[1][0][3][1] * s); }
#pragma unroll
            for (int ai = 0; ai < 2; ++ai)
#pragma unroll
                for (int m = 0; m < 4; ++m) { const float s = inv[ai][m];
#pragma unroll
                    for (int n = 0; n < 2; ++n) { const f32x4 uu = acc[ai][0][m][n] * s, z = acc[ai][1][m][n] * s; f32x4 sg;
#pragma unroll
                        for (int j = 0; j < 4; ++j) sg[j] = 0.f;
                        acc[ai][0][m][n] = uu; acc[ai][1][m][n] = mul_silu4(n ? sc1 : sc0, z); } }
            PROF_STOP(2, lds, wid); PROF_START(3, lds, wid);
#pragma unroll
            for (int n = 0; n < 2; ++n) {
                *(PG8_LAS f32x4*)(HB + (wr * 16 + fr) * HBS + dl + 4 * n) = acc[0][0][3][n];
                if (wr == 0) *(PG8_LAS f32x4*)(HB + (32 + fr) * HBS + dl + 4 * n) = acc[1][0][3][n];
            }
            asm volatile("s_waitcnt lgkmcnt(0)" ::: "memory"); __builtin_amdgcn_s_barrier(); asm volatile("" ::: "memory");
            if (wr == 1) { asm volatile("s_waitcnt vmcnt(0)" ::: "memory"); if (lane == 0) __hip_atomic_fetch_add(myflag, 1u, __ATOMIC_RELAXED, __HIP_MEMORY_SCOPE_AGENT); }
            const int tpos0 = (u.pm * BM + rl) & 8191;
            const float fw = (float)(2 << g);
#define MIXB_RC(ai, m) (need ? (1.0f / fw) : 1.0f / fminf((float)(tpos0 + (ai) * HALF + (m) * 16 + 1), fw))
            PROF_STOP(3, lds, wid); PROF_START(4, lds, wid);
            u32x4 o[2][4];
            { f32x4 pv[2]; pv[0] = *(const PG8_LAS f32x4*)(HB + ((1 + wr) * 16 + fr) * HBS + dl); pv[1] = *(const PG8_LAS f32x4*)(HB + ((1 + wr) * 16 + fr) * HBS + dl + 4);
              o[1][0] = b_block(g, acc[1][0][0], pv, acc[1][1][0], MIXB_RC(1, 0), fr); }
#pragma unroll
            for (int m = 1; m < 4; ++m) o[1][m] = b_block(g, acc[1][0][m], acc[1][0][m - 1], acc[1][1][m], MIXB_RC(1, m), fr);
            PROF_STOP(4, lds, wid); PROF_START(5, lds, wid);
            f32x4 pvg[2]; pvg[0] = zero; pvg[1] = zero;
            if (wr == 1) { pvg[0] = *(const PG8_LAS f32x4*)(HB + fr * HBS + dl); pvg[1] = *(const PG8_LAS f32x4*)(HB + fr * HBS + dl + 4); }
            else if (need) { wait_flag(u, lane); pvg[0] = ld_sc1_f32x4(halo_in + fr * 128 + dl); pvg[1] = ld_sc1_f32x4(halo_in + fr * 128 + dl + 4); }
            PROF_STOP(5, lds, wid); PROF_START(6, lds, wid);
#pragma unroll
            for (int m = 1; m < 4; ++m) o[0][m] = b_block(g, acc[0][0][m], acc[0][0][m - 1], acc[0][1][m], MIXB_RC(0, m), fr);
            o[0][0] = b_block(g, acc[0][0][0], pvg, acc[0][1][0], MIXB_RC(0, 0), fr);
#undef MIXB_RC
            PROF_STOP(6, lds, wid); PROF_START(7, lds, wid);
            bf16_t* yp = Y + (size_t)row0 * 1024 + 512 + 128 * g + dl;
#pragma unroll
            for (int ai = 0; ai < 2; ++ai)
#pragma unroll
                for (int m = 0; m < 4; ++m) st_pay_u32x4(yp + (size_t)(ai * HALF + 16 * m) * 1024, o[ai][m]);
            PROF_STOP(7, lds, wid);
        }
    }
};

template <int MODE> struct EpiRms {
    static constexpr bool PERM = true, AFTER_DRAIN = true;
    const bf16_t* base_b; float* out_f; bf16_t* out_b; float* ssq_out; const float* gpost;
    unsigned long long* xslot; unsigned* tmo; unsigned tag;
    __device__ __forceinline__ void fused(f32x4 (&acc)[2][2][4][2], const Unit& u, int wr, int wc, int fr, int fq, PG8_LAS unsigned char* lds, int wid, int lane) const {
        PG8_LAS float* P = (PG8_LAS float*)lds;
        PG8_LAS float* S = (PG8_LAS float*)(lds + 4096);
        PROF_START(30, lds, wid);
#pragma unroll
        for (int ai = 0; ai < 2; ++ai)
#pragma unroll
            for (int m = 0; m < 4; ++m) { float s = 0.f;
#pragma unroll
                for (int bj = 0; bj < 2; ++bj)
#pragma unroll
                    for (int n = 0; n < 2; ++n) { const f32x4 x = acc[ai][bj][m][n]; s += (x[0] * x[0] + x[1] * x[1]) + (x[2] * x[2] + x[3] * x[3]); }
                s += __shfl_xor(s, 16); s += __shfl_xor(s, 32);
                if (fq == 0) P[(ai * HALF + wr * 64 + m * 16 + fr) * 4 + wc] = s; }
        asm volatile("s_waitcnt lgkmcnt(0)" ::: "memory"); __builtin_amdgcn_s_barrier(); asm volatile("" ::: "memory");
        PROF_STOP(30, lds, wid); PROF_START(31, lds, wid);
        const int row = wid * 32 + (lane & 31);
        unsigned long long* slot = xslot + (size_t)(u.pm * BM + row) * 4;
        if (lane < 32) { const f32x4 p = *(const PG8_LAS f32x4*)(P + row * 4); const float t = (p[0] + p[1]) + (p[2] + p[3]);
            __hip_atomic_store(slot + u.pn, ((unsigned long long)tag << 32) | __float_as_uint(t), __ATOMIC_RELAXED, __HIP_MEMORY_SCOPE_AGENT); }
        const int col0 = u.pn * BM + wc * 32 + 8 * fq;
        const size_t off0 = (size_t)(u.pm * BM + wr * 64 + fr) * 1024 + col0;
        u32x4 rb[2][4][2];
#define RMS_LOAD_RES(ai) do { _Pragma("unroll") for (int m = 0; m < 4; ++m) _Pragma("unroll") for (int bj = 0; bj < 2; ++bj) \
            rb[ai][m][bj] = *(const u32x4*)(base_b + off0 + (size_t)((ai) * HALF + m * 16) * 1024 + bj * HALF); } while (0)
        RMS_LOAD_RES(0);
        f32x4 gv[2][2];
#pragma unroll
        for (int bj = 0; bj < 2; ++bj)
#pragma unroll
            for (int n = 0; n < 2; ++n) gv[bj][n] = *(const f32x4*)(gpost + col0 + bj * HALF + 4 * n);
        PROF_STOP(31, lds, wid); PROF_START(32, lds, wid);
        if (lane < 32) { float t = 0.f; unsigned sp = 0;
            for (;;) { bool ok = true; t = 0.f;
#pragma unroll
                for (int k = 0; k < 4; ++k) { const unsigned long long g = __hip_atomic_load(slot + k, __ATOMIC_RELAXED, __HIP_MEMORY_SCOPE_AGENT); ok &= ((unsigned)(g >> 32) == tag); t += __uint_as_float((unsigned)g); }
                if (ok) break;
                __builtin_amdgcn_s_sleep(1);
                if (++sp > (1u << 20)) { __hip_atomic_store(tmo, 0x700u | (unsigned)u.pm, __ATOMIC_RELAXED, __HIP_MEMORY_SCOPE_AGENT); break; } }
            S[row] = rsqrtf(t * (1.0f / 1024.0f) + 1e-6f); }
        asm volatile("s_waitcnt lgkmcnt(0)" ::: "memory"); __builtin_amdgcn_s_barrier(); asm volatile("" ::: "memory");
        PROF_STOP(32, lds, wid); PROF_START(33, lds, wid);
        RMS_LOAD_RES(1);
#undef RMS_LOAD_RES
        asm volatile("" ::: "memory");
#pragma unroll
        for (int ai = 0; ai < 2; ++ai)
#pragma unroll
            for (int m = 0; m < 4; ++m) { const int r = ai * HALF + wr * 64 + m * 16 + fr; const float iv = S[r]; const size_t off = off0 + (size_t)(ai * HALF + m * 16) * 1024; float q = 0.f;
#pragma unroll
                for (int bj = 0; bj < 2; ++bj) { const u32x4 bb = rb[ai][m][bj];
                    f32x4 b0, b1; b0[0] = __uint_as_float(bb.x << 16); b0[1] = __uint_as_float(bb.x & 0xffff0000u); b0[2] = __uint_as_float(bb.y << 16); b0[3] = __uint_as_float(bb.y & 0xffff0000u);
                    b1[0] = __uint_as_float(bb.z << 16); b1[1] = __uint_as_float(bb.z & 0xffff0000u); b1[2] = __uint_as_float(bb.w << 16); b1[3] = __uint_as_float(bb.w & 0xffff0000u);
                    const f32x4 o0 = b0 + acc[ai][bj][m][0] * iv * gv[bj][0], o1 = b1 + acc[ai][bj][m][1] * iv * gv[bj][1];
                    if (MODE == 0) { q += ((o0[0] * o0[0] + o0[1] * o0[1]) + (o0[2] * o0[2] + o0[3] * o0[3])) + ((o1[0] * o1[0] + o1[1] * o1[1]) + (o1[2] * o1[2] + o1[3] * o1[3]));
                        u32x4 wv; wv.x = cvt_pk_bf16(o0[0], o0[1]); wv.y = cvt_pk_bf16(o0[2], o0[3]); wv.z = cvt_pk_bf16(o1[0], o1[1]); wv.w = cvt_pk_bf16(o1[2], o1[3]); st_pay_u32x4(out_b + off + bj * HALF, wv); }
                    else { __builtin_nontemporal_store(o0, (f32x4*)(out_f + off + bj * HALF)); __builtin_nontemporal_store(o1, (f32x4*)(out_f + off + bj * HALF + 4)); } }
                if (MODE == 0) { q += __shfl_xor(q, 16); q += __shfl_xor(q, 32); if (fq == 0) P[r * 4 + wc] = q; } }
        PROF_STOP(33, lds, wid); PROF_START(34, lds, wid);
        if (MODE == 0) {
            asm volatile("s_waitcnt lgkmcnt(0)" ::: "memory"); __builtin_amdgcn_s_barrier(); asm volatile("" ::: "memory");
            if (lane < 32) { const f32x4 p = *(const PG8_LAS f32x4*)(P + row * 4); st_pay_f32(ssq_out + (size_t)(u.pm * BM + row) * 4 + u.pn, (p[0] + p[1]) + (p[2] + p[3])); }
        }
    }
};

template <class Epi, class Sched, bool ALIGN_EPI = false, bool SP2 = false>
__device__ __forceinline__ void gemm_phase(PG8_LAS unsigned char* lds, const Gemm g, const Sched& S, const Epi& E) {
    const int tid = threadIdx.x, wid = __builtin_amdgcn_readfirstlane(tid >> 6), lane = tid & 63, wr = wid >> 2, wc = wid & 3, fr = lane & 15, fq = lane >> 4;
    const int K = g.K, nt = K / BK;
    unsigned voffA[2], voffB[2];
#pragma unroll
    for (int i = 0; i < 2; ++i) { int R, C; stage_rc(tid * 16 + i * 8192, R, C); const int Rb = Epi::PERM ? ((R & ~31) + perm32(R & 31)) : R;
        voffA[i] = (unsigned)(R * K + C) * 2u; voffB[i] = (unsigned)(Rb * K + C) * 2u; }
    const size_t kstep = (size_t)(BK * 2);
    const size_t hstep = (size_t)HALF * K * 2;
    const size_t tstep = 2 * hstep;
    const unsigned ldsw = (unsigned)wid * 1024u;
    const int aoff = lds_byte(wr * 64 + fr, fq * 8), boff = lds_byte(wc * 32 + fr, fq * 8);
#define PG8_SA(b, h) (((b) * 2 + (h)) * HTB)
#define PG8_SB(b, h) ((4 + (b) * 2 + (h)) * HTB)
#define PG8_STAGE(bufoff, gbase, voff) do { _Pragma("unroll") for (int _i = 0; _i < 2; ++_i) \
        __builtin_amdgcn_global_load_lds((const unsigned*)((const char*)(gbase) + (voff)[_i]), (PG8_LAS unsigned*)(lds + (bufoff) + ldsw + _i * 8192), 16, 0, 0); } while (0)
#define PG8_LDA(dst, b, h) do { _Pragma("unroll") for (int m = 0; m < 4; ++m) _Pragma("unroll") for (int k = 0; k < 2; ++k) dst[m][k] = *(const PG8_LAS bf16x8*)(lds + PG8_SA(b, h) + aoff + m * 2048 + k * 1024); } while (0)
#define PG8_LDB(dst, b, h) do { _Pragma("unroll") for (int n = 0; n < 2; ++n) _Pragma("unroll") for (int k = 0; k < 2; ++k) dst[n][k] = *(const PG8_LAS bf16x8*)(lds + PG8_SB(b, h) + boff + n * 2048 + k * 1024); } while (0)
#define PG8_MMA(ai, bj, At, Bt) do { __builtin_amdgcn_s_setprio(1); _Pragma("unroll") for (int m = 0; m < 4; ++m) _Pragma("unroll") for (int n = 0; n < 2; ++n) _Pragma("unroll") for (int k = 0; k < 2; ++k) \
        acc[ai][bj][m][n] = __builtin_amdgcn_mfma_f32_16x16x32_bf16(Bt[n][k], At[m][k], acc[ai][bj][m][n], 0, 0, 0); __builtin_amdgcn_s_setprio(0); } while (0)
#define PG8_WAIT_V(n) asm volatile("s_waitcnt vmcnt(" #n ")" ::: "memory")
#define PG8_WAIT_L(n) asm volatile("s_waitcnt lgkmcnt(" #n ")" ::: "memory")
#define PG8_BAR __builtin_amdgcn_s_barrier()
#define PG8_SCHED __builtin_amdgcn_sched_barrier(0)
    PROF_START(22, lds, wid);
    Unit cur, nxt; int ui = 0;
    if (!S.next(0, cur)) return;
    f32x4 acc[2][2][4][2];
#pragma unroll
    for (int a = 0; a < 2; ++a)
#pragma unroll
        for (int b = 0; b < 2; ++b)
#pragma unroll
            for (int m = 0; m < 4; ++m)
#pragma unroll
                for (int n = 0; n < 2; ++n) acc[a][b][m][n] = (f32x4){0.f, 0.f, 0.f, 0.f};
    bf16x8 At[4][2], B0[2][2], B1[2][2];
    const char* cA = (const char*)g.A + (size_t)cur.pm * tstep; const char* cB = (const char*)g.Bt + (size_t)cur.pn * tstep;
    S.a_ready(cur);
    if constexpr (SP2) {
        PG8_STAGE(PG8_SB(0, 0), cB, voffB); PG8_STAGE(PG8_SB(0, 1), cB + hstep, voffB); PG8_STAGE(PG8_SA(0, 0), cA, voffA); PG8_STAGE(PG8_SA(0, 1), cA + hstep, voffA);
        if (wr == 1) PG8_BAR;
        PG8_WAIT_V(2); PG8_BAR;
        PG8_STAGE(PG8_SB(1, 0), cB + kstep, voffB); PG8_STAGE(PG8_SA(1, 0), cA + kstep, voffA); PG8_STAGE(PG8_SB(1, 1), cB + hstep + kstep, voffB);
        PG8_WAIT_V(6); PG8_BAR;
    } else {
        PG8_STAGE(PG8_SB(0, 0), cB, voffB); PG8_STAGE(PG8_SA(0, 0), cA, voffA); PG8_STAGE(PG8_SB(0, 1), cB + hstep, voffB); PG8_STAGE(PG8_SA(0, 1), cA + hstep, voffA);
        if (wr == 1) PG8_BAR;
        PG8_WAIT_V(4); PG8_BAR;
        PG8_STAGE(PG8_SB(1, 0), cB + kstep, voffB); PG8_STAGE(PG8_SA(1, 0), cA + kstep, voffA); PG8_STAGE(PG8_SB(1, 1), cB + hstep + kstep, voffB);
        PG8_WAIT_V(6); PG8_BAR;
    }
    PROF_STOP(22, lds, wid);
    for (;;) {
        const bool has_next = S.next(ui + 1, nxt);
        const char* nA = has_next ? (const char*)g.A + (size_t)nxt.pm * tstep : cA; const char* nB = has_next ? (const char*)g.Bt + (size_t)nxt.pn * tstep : cB;
        PROF_START(8, lds, wid);
        asm volatile(".p2align 8");
        for (int t = 0; t < nt; t += 2) {
            const bool last = (t == nt - 2);
            const char* a1 = cA + (size_t)(t + 1) * kstep;
            const char* a2 = last ? nA : cA + (size_t)(t + 2) * kstep; const char* b2 = last ? nB : cB + (size_t)(t + 2) * kstep;
            const char* a3 = a2 + kstep; const char* b3 = b2 + kstep;
            if (last && has_next) S.a_ready(nxt);
            if constexpr (SP2) {
            PG8_LDB(B0, 0, 0); PG8_LDB(B1, 0, 1); PG8_SCHED; PG8_LDA(At, 0, 0); PG8_STAGE(PG8_SA(1, 1), a1 + hstep, voffA);
            PG8_WAIT_V(8); PG8_WAIT_L(0); PG8_BAR; PG8_MMA(0, 0, At, B0); PG8_MMA(0, 1, At, B1); PG8_BAR; PG8_SCHED;
            PG8_LDA(At, 0, 1); PG8_STAGE(PG8_SB(0, 0), b2, voffB); PG8_STAGE(PG8_SB(0, 1), b2 + hstep, voffB); PG8_STAGE(PG8_SA(0, 0), a2, voffA);
            PG8_WAIT_V(8); PG8_WAIT_L(0); PG8_BAR; PG8_MMA(1, 0, At, B0); PG8_MMA(1, 1, At, B1); PG8_BAR; PG8_SCHED;
            PG8_LDB(B0, 1, 0); PG8_LDB(B1, 1, 1); PG8_SCHED; PG8_LDA(At, 1, 0); PG8_STAGE(PG8_SA(0, 1), a2 + hstep, voffA);
            PG8_WAIT_V(8); PG8_WAIT_L(0); PG8_BAR; PG8_MMA(0, 0, At, B0); PG8_MMA(0, 1, At, B1); PG8_BAR; PG8_SCHED;
            PG8_LDA(At, 1, 1); PG8_STAGE(PG8_SB(1, 0), b3, voffB); PG8_STAGE(PG8_SB(1, 1), b3 + hstep, voffB); PG8_STAGE(PG8_SA(1, 0), a3, voffA);
            PG8_WAIT_V(8); PG8_WAIT_L(0); PG8_BAR; PG8_MMA(1, 0, At, B0); PG8_MMA(1, 1, At, B1); PG8_BAR; PG8_SCHED;
            } else {
            PG8_LDB(B0, 0, 0); PG8_SCHED; PG8_LDA(At, 0, 0); PG8_STAGE(PG8_SA(1, 1), a1 + hstep, voffA);
            PG8_WAIT_L(8); PG8_BAR; PG8_WAIT_L(0); PG8_MMA(0, 0, At, B0); PG8_BAR; PG8_SCHED;
            PG8_LDB(B1, 0, 1); PG8_STAGE(PG8_SB(0, 0), b2, voffB);
            PG8_BAR; PG8_WAIT_L(0); PG8_MMA(0, 1, At, B1); PG8_BAR;
            PG8_LDA(At, 0, 1); PG8_STAGE(PG8_SA(0, 0), a2, voffA);
            PG8_BAR; PG8_WAIT_L(0); PG8_MMA(1, 0, At, B0); PG8_BAR; PG8_SCHED;
            PG8_STAGE(PG8_SB(0, 1), b2 + hstep, voffB);
            PG8_WAIT_V(6); PG8_BAR; PG8_MMA(1, 1, At, B1); PG8_BAR;
            PG8_LDB(B0, 1, 0); PG8_SCHED; PG8_LDA(At, 1, 0); PG8_STAGE(PG8_SA(0, 1), a2 + hstep, voffA);
            PG8_WAIT_L(8); PG8_BAR; PG8_WAIT_L(0); PG8_MMA(0, 0, At, B0); PG8_BAR; PG8_SCHED;
            PG8_LDB(B1, 1, 1); PG8_STAGE(PG8_SB(1, 0), b3, voffB);
            PG8_BAR; PG8_WAIT_L(0); PG8_MMA(0, 1, At, B1); PG8_BAR;
            PG8_LDA(At, 1, 1); PG8_STAGE(PG8_SA(1, 0), a3, voffA);
            PG8_BAR; PG8_WAIT_L(0); PG8_MMA(1, 0, At, B0); PG8_BAR; PG8_SCHED;
            PG8_STAGE(PG8_SB(1, 1), b3 + hstep, voffB);
            PG8_WAIT_V(6); PG8_BAR; PG8_MMA(1, 1, At, B1); PG8_BAR;
            }
        }
        PROF_STOP(8, lds, wid); PROF_START(14, lds, wid);
        if constexpr (ALIGN_EPI) { if (wr == 0) PG8_BAR; }
        PROF_STOP(14, lds, wid); PROF_START(1, lds, wid);
        if constexpr (!Epi::AFTER_DRAIN) { E(acc, cur, wr, wc, fr, fq, lds, wid, lane); S.done(cur); }
        PROF_STOP(1, lds, wid);
        if (!has_next) break;
#pragma unroll
        for (int a = 0; a < 2; ++a)
#pragma unroll
            for (int b = 0; b < 2; ++b)
#pragma unroll
                for (int m = 0; m < 4; ++m)
#pragma unroll
                    for (int n = 0; n < 2; ++n) acc[a][b][m][n] = (f32x4){0.f, 0.f, 0.f, 0.f};
        cur = nxt; cA = nA; cB = nB; ++ui;
        if constexpr (ALIGN_EPI) { if (wr == 1) PG8_BAR; }
    }
    PROF_START(23, lds, wid);
    PG8_WAIT_V(0);
    if constexpr (!ALIGN_EPI) { if (wr == 0) PG8_BAR; }
    PG8_BAR;
    PROF_STOP(23, lds, wid); PROF_START(11, lds, wid);
    if constexpr (Epi::AFTER_DRAIN) { E.fused(acc, cur, wr, wc, fr, fq, lds, wid, lane); S.done(cur); }
    PROF_STOP(11, lds, wid);
#undef PG8_SA
#undef PG8_SB
#undef PG8_STAGE
#undef PG8_LDA
#undef PG8_LDB
#undef PG8_MMA
#undef PG8_WAIT_V
#undef PG8_WAIT_L
#undef PG8_BAR
#undef PG8_SCHED
}
}

constexpr int NWAVES = 8;
#ifndef MK_N_LAUNCHES
#define MK_N_LAUNCHES 1
#endif
constexpr int N_LAUNCHES = MK_N_LAUNCHES;
constexpr int N_PHASES = 5;

constexpr int D = 1024, BATCH = 2, SEQ = 8192, DEPTH = 2, M = BATCH * SEQ, NIN = 3072;
constexpr size_t MiB = 1u << 20;
constexpr size_t WS_CTL = 0, CTL_ZERO_BYTES = 192 * 1024;
constexpr size_t WS_W1T = 2 * MiB;
constexpr size_t WS_W2T = 14 * MiB;
constexpr size_t WS_SSQ = 18 * MiB;
constexpr size_t WS_XSLOT = 19 * MiB;
constexpr size_t WS_HALO = 20 * MiB;
constexpr size_t WS_XB = 32 * MiB;
constexpr size_t WS_Y = 64 * MiB;
constexpr size_t WS_HGA = 96 * MiB;
constexpr size_t WS_END = 97 * MiB;
constexpr int CW_TMO = 0, CW_BAR = 4096, CW_CNT = 8192, CW_XCC = 12288, CW_FLAG = 16384;
static_assert((CW_FLAG + 2 * 768 * 16) * 4 <= (int)CTL_ZERO_BYTES, "ctl words inside the memset region");

constexpr int RING_BYTES = 131072;
constexpr int HB_OFF = RING_BYTES;
constexpr int MISC_OFF = pg8::EPI_MISC_OFF;
constexpr int LDS_BYTES = pg8::EPI_LDS_END;
constexpr int SCR_STRIDE = 17408;
static_assert(pg8::HB_BYTES <= 25600 && 8 * SCR_STRIDE <= MISC_OFF && LDS_BYTES <= 160 * 1024, "LDS map");

#define GAS __attribute__((address_space(1)))
#define LAS __attribute__((address_space(3)))
typedef unsigned short bf16;
typedef unsigned v4u __attribute__((ext_vector_type(4)));
typedef unsigned v2u __attribute__((ext_vector_type(2)));
typedef float f32x4 __attribute__((ext_vector_type(4)));
typedef float f32x16 __attribute__((ext_vector_type(16)));
#define LDS_WAIT() asm volatile("s_waitcnt lgkmcnt(0)" ::: "memory")
#define VM_WAIT() asm volatile("s_waitcnt vmcnt(0)" ::: "memory")
__device__ __forceinline__ unsigned f2bf(float f) { unsigned u = __builtin_bit_cast(unsigned, f); return (u + 0x7fffu + ((u >> 16) & 1u)) >> 16; }
__device__ __forceinline__ unsigned pk2(float lo, float hi) { return f2bf(lo) | (f2bf(hi) << 16); }

#define XB_TMO      128
#define XB_XCNT(j)  (256  + 64 * (j))
#define XB_XSUB(j)  (1280 + 64 * (j))
#define XB_XGEN(j)  (2304 + 64 * (j))
#define XB_TOP      3328
#define XB_TOPGEN   3392
#define XCD_BAR_WORDS 3456
#define XB_SPIN_CAP (1u << 18)

__device__ __forceinline__ unsigned xb_ld(unsigned* p)              { return __hip_atomic_load(p, __ATOMIC_RELAXED, __HIP_MEMORY_SCOPE_AGENT); }
__device__ __forceinline__ unsigned xb_add(unsigned* p, unsigned v) { return __hip_atomic_fetch_add(p, v, __ATOMIC_RELAXED, __HIP_MEMORY_SCOPE_AGENT); }
__device__ __forceinline__ unsigned xb_xcc_id() { return (unsigned)__builtin_amdgcn_s_getreg((3 << 11) | 20) & 0xFu; }
#define XB_SPIN(cond, bar) do { unsigned _sp = 0; while (cond) { __builtin_amdgcn_s_sleep(1); \
    if ((++_sp & 255u) == 0u) { if (xb_ld(&(bar)[XB_TMO])) break; if (_sp > XB_SPIN_CAP) { atomicAdd(&(bar)[XB_TMO], 1u); break; } } } } while (0)

struct XcdBarrier {
    unsigned* bar; unsigned x;
    volatile LAS unsigned* st;
};

__device__ __forceinline__ XcdBarrier xcd_barrier_post(unsigned* bar, volatile LAS unsigned* st) {
    XcdBarrier b; b.bar = bar; b.x = xb_xcc_id(); b.st = st;
    if (threadIdx.x == 0) (void)xb_add(&bar[XB_XCNT(b.x)], 1u);
    return b;
}
__device__ __forceinline__ void xcd_barrier_complete(unsigned* bar, unsigned x, unsigned& nloc, unsigned& nx) {
    const unsigned G = gridDim.x * gridDim.y * gridDim.z;
    unsigned sum, cnt, mine, sp = 0u;
    for (;;) {
        sum = 0u; cnt = 0u; mine = 0u;
#pragma unroll
        for (unsigned j = 0; j < 16; ++j) { const unsigned c = xb_ld(&bar[XB_XCNT(j)]); sum += c; cnt += (c > 0u) ? 1u : 0u; mine = (j == x) ? c : mine; }
        if (sum == G) break;
        __builtin_amdgcn_s_sleep(1);
        if ((++sp & 255u) == 0u) { if (xb_ld(&bar[XB_TMO])) break; if (sp > XB_SPIN_CAP) { atomicAdd(&bar[XB_TMO], 1u); break; } }
    }
    nloc = mine > 0u ? mine : 1u; nx = cnt > 0u ? cnt : 1u;
}

__device__ __forceinline__ void xcd_barrier(const XcdBarrier& b, bool leader_wb = true, bool self_wb = false) {
    asm volatile("s_waitcnt vmcnt(0)" ::: "memory");
    __syncthreads();
    if (threadIdx.x == 0) {
        unsigned* bar = b.bar;
        if (self_wb) { __builtin_amdgcn_fence(__ATOMIC_RELEASE, "agent"); asm volatile("s_waitcnt vmcnt(0)" ::: "memory"); }
        __builtin_amdgcn_s_waitcnt(0);
        unsigned nloc = b.st[0], nx = b.st[1];
        if (nloc == 0u) { xcd_barrier_complete(bar, b.x, nloc, nx); b.st[0] = nloc; b.st[1] = nx; }
        const unsigned old = xb_add(&bar[XB_XSUB(b.x)], 1u);
        const unsigned gen = old / nloc;
        if (old + 1u == (gen + 1u) * nloc) {
            if (leader_wb) __builtin_amdgcn_fence(__ATOMIC_RELEASE, "agent");
            asm volatile("s_waitcnt vmcnt(0)" ::: "memory");
            const unsigned og = xb_add(&bar[XB_TOP], 1u);
            const unsigned tg = og / nx;
            if (og + 1u == (tg + 1u) * nx) xb_add(&bar[XB_TOPGEN], 1u);
            else XB_SPIN(xb_ld(&bar[XB_TOPGEN]) == tg, bar);
            __builtin_amdgcn_fence(__ATOMIC_ACQUIRE, "agent");
            xb_add(&bar[XB_XGEN(b.x)], 1u);
            asm volatile("s_waitcnt vmcnt(0)" ::: "memory");
        } else {
            XB_SPIN(xb_ld(&bar[XB_XGEN(b.x)]) == gen, bar);
            __builtin_amdgcn_fence(__ATOMIC_ACQUIRE, "agent");
            asm volatile("s_waitcnt vmcnt(0)" ::: "memory");
        }
    }
    __syncthreads();
}


__device__ __forceinline__ void seam_arrive(unsigned* word, bool fence) {
    asm volatile("s_waitcnt vmcnt(0)" ::: "memory");
    __syncthreads();
    if (threadIdx.x == 0) {
        if (fence) { __builtin_amdgcn_fence(__ATOMIC_RELEASE, "agent"); asm volatile("s_waitcnt vmcnt(0)" ::: "memory"); }
        (void)__hip_atomic_fetch_add(word, 1u, __ATOMIC_RELAXED, __HIP_MEMORY_SCOPE_AGENT);
    }
}
__device__ __forceinline__ void seam_wait(unsigned* word, unsigned want, unsigned* tmo, unsigned code) {
    if (threadIdx.x < 64) { unsigned sp = 0;
        __builtin_amdgcn_fence(__ATOMIC_ACQUIRE, "agent");
        while ((unsigned)__builtin_amdgcn_readfirstlane(__hip_atomic_load(word, __ATOMIC_RELAXED, __HIP_MEMORY_SCOPE_AGENT)) < want) { __builtin_amdgcn_s_sleep(1);
            if (++sp > (1u << 20)) { if (threadIdx.x == 0) __hip_atomic_store(tmo, code, __ATOMIC_RELAXED, __HIP_MEMORY_SCOPE_AGENT); break; } }
        asm volatile("s_waitcnt vmcnt(0)" ::: "memory"); }
    __syncthreads();
}

__device__ __forceinline__ float wave_sum(float v) {
#pragma unroll
    for (int o = 1; o < 64; o <<= 1) v += __shfl_xor(v, o);
    return v;
}
__device__ __forceinline__ int w1_srccol(int n) {
    const int pn = n >> 8, c = n & 255, bj = c >> 7, wc = (c >> 5) & 3, nn = (c >> 4) & 1, fq = (c >> 2) & 3, j = c & 3;
    if (pn < 8) return (2 * bj + nn) * 512 + 64 * pn + 16 * wc + 4 * fq + j;
    if (bj == 0) return -1;
    return 2560 + 128 * (pn - 8) + 32 * wc + 8 * fq + 4 * nn + j;
}
struct TrItem { const float* W; const float* gs; bf16* WT; int ldw, n0, srccol, k0; };
__device__ __forceinline__ void tr_load(const TrItem& d, int lane, float (&v)[32]) {
#pragma unroll
    for (int i = 0; i < 32; ++i) v[i] = __builtin_nontemporal_load(d.W + (size_t)(d.k0 + 2 * i + (lane >> 5)) * d.ldw + d.srccol);
}
__device__ __forceinline__ void tr_finish(const TrItem& d, const float (&v)[32], LAS float* scr, int lane) {
    const int c = lane & 7;
    f32x4 g0 = {1.f, 1.f, 1.f, 1.f}, g1 = g0;
    if (d.gs) { g0 = *(const f32x4*)(d.gs + d.k0 + 8 * c); g1 = *(const f32x4*)(d.gs + d.k0 + 8 * c + 4); }
#pragma unroll
    for (int i = 0; i < 32; ++i) scr[(2 * i + (lane >> 5)) * 33 + (lane & 31)] = v[i];
    LDS_WAIT(); asm volatile("" ::: "memory");
#pragma unroll
    for (int j = 0; j < 4; ++j) { const int n = (lane >> 3) + 8 * j; const LAS float* s = scr + (8 * c) * 33 + n;
        v4u o; o.x = pk2(s[0 * 33] * g0[0], s[1 * 33] * g0[1]); o.y = pk2(s[2 * 33] * g0[2], s[3 * 33] * g0[3]); o.z = pk2(s[4 * 33] * g1[0], s[5 * 33] * g1[1]); o.w = pk2(s[6 * 33] * g1[2], s[7 * 33] * g1[3]);
        asm volatile("global_store_dwordx4 %0, %1, off sc1\n\ts_nop 1" :: "v"(d.WT + (size_t)(d.n0 + n) * D + d.k0 + 8 * c), "v"(o) : "memory"); }
    LDS_WAIT(); asm volatile("" ::: "memory");
}
__device__ __forceinline__ void p0_pool_item(const float* win, const float* gpre, const float* wpool, bf16* W1T, LAS float* scr, int item, int lane) {
    const int db = item & 3, g = (item >> 2) & 3, kb = item >> 4;
    const int k0 = 32 * kb, d0 = 32 * db, i = lane & 31, h = lane >> 5;
    float b[64];
#pragma unroll
    for (int s = 0; s < 64; ++s) b[s] = wpool[(size_t)(g * 128 + 2 * s + h) * 128 + d0 + i];
#pragma unroll
    for (int r = 0; r < 16; ++r) { const int kk = 2 * r + h; const f32x4 v = *(const f32x4*)(win + (size_t)(k0 + kk) * NIN + 2048 + 128 * g + 4 * i); const float gs = gpre[k0 + kk];
        LAS float* d = scr + kk * 129 + 4 * i; d[0] = v[0] * gs; d[1] = v[1] * gs; d[2] = v[2] * gs; d[3] = v[3] * gs; }
    LDS_WAIT(); asm volatile("" ::: "memory");
    f32x16 acc;
#pragma unroll
    for (int r = 0; r < 16; ++r) acc[r] = 0.f;
#pragma unroll
    for (int s = 0; s < 64; ++s) { const float a = scr[i * 129 + 2 * s + h]; acc = __builtin_amdgcn_mfma_f32_32x32x2f32(a, b[s], acc, 0, 0, 0); }
    const int d = d0 + i, n = 256 * (8 + g) + 32 * (d >> 5) + 16 * ((d >> 2) & 1) + 4 * ((d >> 3) & 3) + (d & 3);
#pragma unroll
    for (int q = 0; q < 4; ++q) { v2u o; o.x = pk2(acc[4 * q + 0], acc[4 * q + 1]); o.y = pk2(acc[4 * q + 2], acc[4 * q + 3]); __hip_atomic_store((unsigned long long*)(W1T + (size_t)n * D + k0 + 8 * q + 4 * h), ((unsigned long long)o.y << 32) | o.x, __ATOMIC_RELAXED, __HIP_MEMORY_SCOPE_AGENT); }
    LDS_WAIT(); asm volatile("" ::: "memory");
}

struct Args { const float* in[9]; float* out; unsigned char* ws; int ph_lo, ph_hi; };

__device__ __forceinline__ void p0_prologue(const Args& a, LAS unsigned char* lds, int gw, int NGW, int wave, int lane) {
    LAS float* scr = (LAS float*)(lds + wave * SCR_STRIDE);
    const float* x = a.in[0]; const float* pre_norm = a.in[1]; const float* w_in = a.in[2]; const float* w_pool = a.in[5]; const float* w_out = a.in[7];
    bf16* W1T = (bf16*)(a.ws + WS_W1T); bf16* W2T = (bf16*)(a.ws + WS_W2T); bf16* XB = (bf16*)(a.ws + WS_XB); float* SSQ = (float*)(a.ws + WS_SSQ);
    constexpr int I_POOL = DEPTH * 512, I_W1 = DEPTH * 80 * 16, I_W2 = DEPTH * 32 * 16, I_TR = I_W1 + I_W2;
    { unsigned long long* xs = (unsigned long long*)(a.ws + WS_XSLOT);
      for (int i = gw * 64 + lane; i < DEPTH * M * 4; i += NGW * 64) __hip_atomic_store(xs + i, 0ull, __ATOMIC_RELAXED, __HIP_MEMORY_SCOPE_AGENT);
      unsigned long long* hz = (unsigned long long*)(a.ws + WS_HGA);
      for (int i = gw * 64 + lane; i < DEPTH * 8 * 64 * 128; i += NGW * 64) __hip_atomic_store(hz + i, 0ull, __ATOMIC_RELAXED, __HIP_MEMORY_SCOPE_AGENT); }
#define P0_TR_DESC(d, r_) do { int r = (r_); \
        if (r < I_W1) { const int l = r / 1280, q = r % 1280, nbi = q % 80, kb = q / 80;     \
            const int n0 = nbi < 64 ? 32 * nbi : 256 * (8 + ((nbi - 64) >> 2)) + 128 + 32 * ((nbi - 64) & 3); \
            d.W = w_in + (size_t)l * D * NIN; d.gs = pre_norm + l * D; d.WT = W1T + (size_t)l * NIN * D; d.ldw = NIN; d.n0 = n0; d.srccol = w1_srccol(n0 + (lane & 31)); d.k0 = 64 * kb; } \
        else { r -= I_W1; const int l = r >> 9, q = r & 511, nb = q & 31, kb = q >> 5; \
            d.W = w_out + (size_t)l * D * D; d.gs = nullptr; d.WT = W2T + (size_t)l * D * D; d.ldw = D; d.n0 = 32 * nb; d.srccol = 32 * nb + (lane & 31); d.k0 = 64 * kb; } } while (0)
    if (NGW == 2048) {
        if (gw < I_POOL) {
            TrItem d; float v[32]; const bool has = gw < I_TR - 3 * 1024;
            if (has) { P0_TR_DESC(d, 3 * 1024 + gw); tr_load(d, lane, v); }
            { const int l = gw >> 9; p0_pool_item(w_in + (size_t)l * D * NIN, pre_norm + l * D, w_pool + (size_t)l * 4 * 128 * 128, W1T + (size_t)l * NIN * D, scr, gw & 511, lane); }
            if (has) tr_finish(d, v, scr, lane);
        } else {
            TrItem d0, d1, d2; float v0[32], v1[32], v2[32]; const int t0 = (gw - 1024) * 3;
            P0_TR_DESC(d0, t0); tr_load(d0, lane, v0); P0_TR_DESC(d1, t0 + 1); tr_load(d1, lane, v1); P0_TR_DESC(d2, t0 + 2); tr_load(d2, lane, v2);
            tr_finish(d0, v0, scr, lane); tr_finish(d1, v1, scr, lane); tr_finish(d2, v2, scr, lane);
        }
    } else {
        for (int it = gw; it < I_POOL + I_TR; it += NGW) {
            if (it < I_POOL) { const int l = it >> 9; p0_pool_item(w_in + (size_t)l * D * NIN, pre_norm + l * D, w_pool + (size_t)l * 4 * 128 * 128, W1T + (size_t)l * NIN * D, scr, it & 511, lane); }
            else { TrItem d; float v[32]; P0_TR_DESC(d, it - I_POOL); tr_load(d, lane, v); tr_finish(d, v, scr, lane); }
        }
    }
#undef P0_TR_DESC
    const int xstep = (NGW == 2048) ? 1 : NGW, xc = gw >> 3;
    const int xfirst = (NGW == 2048) ? (8 * (xc & 7) + ((xc >> 3) & 7)) * 256 + (xc >> 6) * 64 + (gw & 7) * 8 : gw, xend = (NGW == 2048) ? xfirst + 8 : M;
    for (int r0 = xfirst; r0 < xend; r0 += 4 * xstep) {
        f32x4 v[4][4];
#pragma unroll
        for (int q = 0; q < 4; ++q) { const f32x4* xr = (const f32x4*)(x + (size_t)(r0 + q * xstep) * D) + lane;
#pragma unroll
            for (int j = 0; j < 4; ++j) v[q][j] = (r0 + q * xstep < M) ? __builtin_nontemporal_load(xr + 64 * j) : (f32x4){0.f, 0.f, 0.f, 0.f}; }
#pragma unroll
        for (int q = 0; q < 4; ++q) { const int r = r0 + q * xstep; if (r >= M) break; float s = 0.f;
#pragma unroll
            for (int j = 0; j < 4; ++j) s += (v[q][j][0] * v[q][j][0] + v[q][j][1] * v[q][j][1]) + (v[q][j][2] * v[q][j][2] + v[q][j][3] * v[q][j][3]);
            s = wave_sum(s);
            if (lane == 0) *(f32x4*)(SSQ + (size_t)r * 4) = (f32x4){s, 0.f, 0.f, 0.f};
            v2u* o8 = (v2u*)(XB + (size_t)r * D) + lane;
#pragma unroll
            for (int j = 0; j < 4; ++j) { v2u o; o.x = pk2(v[q][j][0], v[q][j][1]); o.y = pk2(v[q][j][2], v[q][j][3]); o8[64 * j] = o; } }
    }
}

__global__ void __launch_bounds__(NWAVES * 64, 2) mk_fwd(Args args) {
    extern __shared__ __attribute__((aligned(16))) unsigned char lds_raw[];
    LAS unsigned char* lds = (LAS unsigned char*)lds_raw;
    volatile LAS unsigned* MISC = (volatile LAS unsigned*)(lds + MISC_OFF);
    const int tid = threadIdx.x, lane = tid & 63, wave = __builtin_amdgcn_readfirstlane(tid >> 6);
    const int G = gridDim.x;
    unsigned char* ws = args.ws;
    unsigned* ctl = (unsigned*)(ws + WS_CTL);
    if (tid < 64) MISC[tid] = 0u;
    __syncthreads();
    if (tid == 0) __hip_atomic_store(ctl + CW_XCC + blockIdx.x, xb_xcc_id() + 1u, __ATOMIC_RELAXED, __HIP_MEMORY_SCOPE_AGENT);
    XcdBarrier bar; bar.bar = ctl + CW_BAR; bar.x = 0; bar.st = nullptr;
    if (N_LAUNCHES == 1) bar = xcd_barrier_post(ctl + CW_BAR, MISC + 8);
#define GRID_BAR() do { if (N_LAUNCHES == 1) xcd_barrier(bar); } while (0)
    const int lo = args.ph_lo, hi = args.ph_hi;
#define IN(k) (lo <= (k) && (k) < hi)
    bf16* W1T = (bf16*)(ws + WS_W1T); bf16* W2T = (bf16*)(ws + WS_W2T); bf16* XB = (bf16*)(ws + WS_XB); bf16* Y = (bf16*)(ws + WS_Y);
    float* SSQ = (float*)(ws + WS_SSQ);

#define PHASE_P0() do { if (IN(0)) { PROF_START(25, lds, wave); p0_prologue(args, lds, blockIdx.x * NWAVES + wave, G * NWAVES, wave, lane); PROF_STOP(25, lds, wave); PROF_START(24, lds, wave); P0_PARTNERS(); if (N_LAUNCHES == 1) { if (quad) xcd_barrier(bar, false, MISC[17] != 0u); else xcd_barrier(bar); } PROF_STOP(24, lds, wave); } } while (0)
    int my_pm; { pg8::StaticOrder S; S.init(M, NIN, G, (int)blockIdx.x); pg8::Unit u0, u1; S.next(0, u0); my_pm = u0.pm; bool same = true; for (int i = 1; S.next(i, u1); ++i) same &= (u1.pm == u0.pm);
                 pg8::StaticOrder S2; S2.init(M, D, G, (int)blockIdx.x); S2.next(0, u1); same &= (u1.pm == u0.pm) && G == 256; if (!same) my_pm = -1; }
    const bool quad = (MK_QUAD != 0) && N_LAUNCHES == 1 && my_pm >= 0;
    unsigned* seamw = ctl + CW_CNT + (my_pm < 0 ? 0 : my_pm) * 16;
#define SEAM_DONE(s_) do { PROF_START(21, lds, wave); if (quad) seam_arrive(seamw + (s_) * 1024, MISC[17] != 0u); else GRID_BAR(); PROF_STOP(21, lds, wave); } while (0)
#define SEAM_WAIT(s_) do { PROF_START(20, lds, wave); if (quad) seam_wait(seamw + (s_) * 1024, 4u, ctl + CW_TMO, 0x600u + (s_)); PROF_STOP(20, lds, wave); } while (0)
#define PHASE_G1(l) do { if (IN(1 + 2 * (l))) { \
            if ((l) > 0) SEAM_WAIT(1); \
            pg8::Gemm g{XB, W1T + (size_t)(l) * NIN * D, M, NIN, D}; pg8::StaticOrder S; S.init(M, NIN, G, (int)blockIdx.x); \
            pg8::EpiMix E{Y, SSQ, args.in[3] + (size_t)(l) * 3 * 512, args.in[4] + (size_t)(l) * 512, args.in[6] + (size_t)(l) * 512, \
                          (float*)(ws + WS_HALO) + (size_t)(l) * 768 * pg8::HALO_TILE, ctl + CW_FLAG + (l) * 768 * 16, ctl + CW_TMO, (unsigned)((l) + 1), (unsigned long long*)(ws + WS_HGA) + (size_t)(l) * 8 * 64 * 128}; \
            pg8::gemm_phase<pg8::EpiMix, pg8::StaticOrder, true, true>(lds, g, S, E); \
            SEAM_DONE(2 * (l)); } } while (0)
#define PHASE_G2_0() do { if (IN(2)) { \
        SEAM_WAIT(0); \
        pg8::Gemm g{Y, W2T, M, D, D}; pg8::StaticOrder S; S.init(M, D, G, (int)blockIdx.x); \
        pg8::EpiRms<0> E{XB, nullptr, XB, SSQ, args.in[8], (unsigned long long*)(ws + WS_XSLOT), ctl + CW_TMO, 1u}; \
        pg8::gemm_phase<pg8::EpiRms<0>, pg8::StaticOrder, false, true>(lds, g, S, E); SEAM_DONE(1); } } while (0)
#define PHASE_G2_1(last) do { if (IN(4)) { \
        SEAM_WAIT(2); \
        pg8::Gemm g{Y, W2T + (size_t)D * D, M, D, D}; pg8::StaticOrder S; S.init(M, D, G, (int)blockIdx.x); \
        pg8::EpiRms<1> E{XB, args.out, nullptr, nullptr, args.in[8] + D, (unsigned long long*)(ws + WS_XSLOT) + (size_t)M * 4, ctl + CW_TMO, 2u}; \
        pg8::gemm_phase<pg8::EpiRms<1>, pg8::StaticOrder, false, true>(lds, g, S, E); if (!(last)) GRID_BAR(); } } while (0)
#define P0_PARTNERS() do { if (quad && tid == 0) { \
        const unsigned c0 = (blockIdx.x & 7u) + 8u * ((blockIdx.x >> 3) & 7u); const unsigned mine = xb_xcc_id() + 1u; unsigned diff = 0u; \
        for (unsigned k = 0; k < 4; ++k) { unsigned v = 0u, sp = 0u; \
            while ((v = __hip_atomic_load(ctl + CW_XCC + c0 + 64u * k, __ATOMIC_RELAXED, __HIP_MEMORY_SCOPE_AGENT)) == 0u && ++sp < (1u << 16)) __builtin_amdgcn_s_sleep(1); \
            diff |= (v != mine) ? 1u : 0u; } \
        MISC[17] = diff; } \
    __syncthreads(); } while (0)
    PHASE_P0();
    PHASE_G1(0);
    PHASE_G2_0();
    PHASE_G1(1);
    PHASE_G2_1(true);
#undef PHASE_P0
#undef P0_PARTNERS
#undef SEAM_DONE
#undef SEAM_WAIT
#undef PHASE_G2_0
#undef PHASE_G2_1
    if (PROF_ID != 0 && blockIdx.x == PROF_BLOCK && tid == 0) {
        const unsigned long long t0 = __builtin_amdgcn_s_memrealtime();
#ifdef PROF_CLK
        const unsigned long long want = (unsigned long long)MISC[20] / 10u;
#else
        const unsigned long long want = (unsigned long long)MISC[20] * PROF_SCALE;
#endif

        while (__builtin_amdgcn_s_memrealtime() - t0 < want) __builtin_amdgcn_s_sleep(8);
    }
#undef PHASE_G1
#undef IN
#undef GRID_BAR
}

extern "C" void kernel_launch(void* const* d_in, const int* in_sizes, int n_in, void* d_out, int out_size, void* d_ws, size_t ws_size, hipStream_t stream) {
    static int grid = 0;
    if (grid == 0) {
        if (n_in != 9 || in_sizes[0] != M * D || out_size != M * D || ws_size < WS_END) { fprintf(stderr, "kernel_launch: unexpected shapes (n_in %d, in0 %d, out %d, ws %zu); nothing launched\n", n_in, n_in > 0 ? in_sizes[0] : -1, out_size, ws_size); grid = -1; return; }
        int dev = 0, cus = 0, per_cu = 0;
        if (hipGetDevice(&dev) != hipSuccess || hipDeviceGetAttribute(&cus, hipDeviceAttributeMultiprocessorCount, dev) != hipSuccess) { grid = -1; return; }
        if (hipFuncSetAttribute((const void*)mk_fwd, hipFuncAttributeMaxDynamicSharedMemorySize, LDS_BYTES) != hipSuccess) { fprintf(stderr, "kernel_launch: hipFuncSetAttribute failed\n"); grid = -1; return; }
        if (hipOccupancyMaxActiveBlocksPerMultiprocessor(&per_cu, (const void*)mk_fwd, NWAVES * 64, LDS_BYTES) != hipSuccess || per_cu < 1) fprintf(stderr, "kernel_launch: occupancy query reports %d blocks per CU\n", per_cu);
        (void)hipGetLastError();
        grid = cus;
        if (grid != 256) fprintf(stderr, "kernel_launch: %d CUs; the fused GEMM2 epilogue expects 256 workgroups\n", grid);
    }
    if (grid < 0) return;
    (void)hipMemsetAsync((char*)d_ws + WS_CTL, 0, CTL_ZERO_BYTES, stream);
    Args a{};
    for (int i = 0; i < 9; ++i) a.in[i] = (const float*)d_in[i];
    a.out = (float*)d_out; a.ws = (unsigned char*)d_ws;
    for (int li = 0; li < N_LAUNCHES; ++li) {
        a.ph_lo = (N_LAUNCHES == 1) ? 0 : li; a.ph_hi = (N_LAUNCHES == 1) ? N_PHASES : li + 1;
        hipLaunchKernelGGL(mk_fwd, dim3(grid), dim3(NWAVES * 64), LDS_BYTES, stream, a);
    }
}
```

```cpp
#include <hip/hip_runtime.h>
#include <cstdio>
#include <cstdint>
#ifndef MK_QUAD
#define MK_QUAD 1
#endif
namespace pg8 {
#define PG8_LAS __attribute__((address_space(3)))
typedef unsigned short bf16_t;
typedef short bf16x8 __attribute__((ext_vector_type(8)));
typedef float f32x4 __attribute__((ext_vector_type(4)));
typedef unsigned u32x4 __attribute__((ext_vector_type(4)));
constexpr int BM = 256, BK = 64, HALF = 128, HTB = HALF * BK * 2  , STAGE_BYTES = 8 * HTB, NXCD = 8, WGM = 8;

__host__ __device__ __forceinline__ int lds_byte(int r, int c) { const int st = (r >> 4) * 2 + (c >> 5), rr = r & 15, cc = c & 31, ob = rr * 64 + cc * 2; return st * 1024 + (ob ^ (((ob >> 9) & 1) << 5)); }
__host__ __device__ __forceinline__ void stage_rc(int b, int& R, int& C) { const int st = b / 1024, sb = b % 1024, swz = sb ^ (((sb >> 9) & 1) << 5); R = (st >> 1) * 16 + swz / 64; C = (st & 1) * 32 + (swz % 64) / 2; }
__host__ __device__ __forceinline__ int perm32(int rho) { const int n = rho >> 4, i = rho & 15; return 8 * (i >> 2) + 4 * n + (i & 3); }

struct Unit { int pm, pn; };
struct Gemm { const bf16_t* A; const bf16_t* Bt; int M, N, K; };

struct StaticOrder {
    int nM, nN, nwg, G, c;
    __host__ __device__ __forceinline__ void init(int M, int N, int G_, int c_) { nM = M / BM; nN = N / BM; nwg = nM * nN; G = G_; c = c_; }
    __host__ __device__ __forceinline__ bool next(int i, Unit& u) const {
        const long L = (long)i * G + c; if (L >= nwg) return false;
        int wgid = (int)L; { const int q = nwg / NXCD, r = nwg % NXCD, xcd = wgid % NXCD, off = wgid / NXCD; wgid = (xcd < r ? xcd * (q + 1) : r * (q + 1) + (xcd - r) * q) + off; }
        const int nig = WGM * nN, gid = wgid / nig, fm = gid * WGM, gsz = (nM - fm) < WGM ? (nM - fm) : WGM;
        u.pm = fm + ((wgid % nig) % gsz); u.pn = (wgid % nig) / gsz; return true;
    }
    __device__ __forceinline__ void a_ready(const Unit&) const {}
    __device__ __forceinline__ void done(const Unit&) const {}
};


typedef unsigned u32x2 __attribute__((ext_vector_type(2)));
typedef int i32x4 __attribute__((ext_vector_type(4)));
__device__ __forceinline__ unsigned cvt_pk_bf16(float lo, float hi) { unsigned r; asm volatile("v_cvt_pk_bf16_f32 %0, %1, %2" : "=v"(r) : "v"(lo), "v"(hi)); return r; }
__device__ __forceinline__ float silu_f(float z) { return z * __builtin_amdgcn_rcpf(1.0f + __expf(-z)); }
__device__ __forceinline__ f32x4 mul_silu4(const f32x4& x, const f32x4& z) {
    const f32x4 t = z * (-1.44269504089f);
    f32x4 e; e[0] = __builtin_amdgcn_exp2f(t[0]); e[1] = __builtin_amdgcn_exp2f(t[1]); e[2] = __builtin_amdgcn_exp2f(t[2]); e[3] = __builtin_amdgcn_exp2f(t[3]);
    const f32x4 d = e + 1.0f;
    f32x4 r; r[0] = __builtin_amdgcn_rcpf(d[0]); r[1] = __builtin_amdgcn_rcpf(d[1]); r[2] = __builtin_amdgcn_rcpf(d[2]); r[3] = __builtin_amdgcn_rcpf(d[3]);
    return (x * z) * r;
}
template <int K> __device__ __forceinline__ float shl_prev(float cur, float prev) {
    const int t = __builtin_amdgcn_update_dpp(0, __float_as_int(prev), 0x120 + K, 0xf, 0xf, false);
    return __int_as_float(__builtin_amdgcn_update_dpp(t, __float_as_int(cur), 0x110 + K, 0xf, 0xf, false));
}
template <int K> __device__ __forceinline__ float shl_zero(float cur) { return __int_as_float(__builtin_amdgcn_update_dpp(0, __float_as_int(cur), 0x110 + K, 0xf, 0xf, true)); }

constexpr int HBS = 132;
constexpr int HB_BYTES = 3 * 16 * HBS * 4;
constexpr int HALO_TILE = 16 * 128;
constexpr int EPI_HB_OFF = STAGE_BYTES, EPI_MISC_OFF = EPI_HB_OFF + 25600, EPI_INV_OFF = EPI_MISC_OFF + 256, EPI_LDS_END = EPI_INV_OFF + 1024;
static_assert(HB_BYTES <= 25600, "halo images");

#ifndef PROF_ID
#define PROF_ID 0
#endif
#ifndef PROF_BLOCK
#define PROF_BLOCK 9
#endif
#ifndef PROF_WAVE
#define PROF_WAVE 0
#endif
#define PROF_SCALE 20u
#ifdef PROF_CLK
#define PROF_NOW() ((unsigned)__builtin_amdgcn_s_memtime())
#else
#define PROF_NOW() ((unsigned)__builtin_amdgcn_s_memrealtime())
#endif
#define PROF_START(n, lds_, wid_) do { if (PROF_ID == (n) && blockIdx.x == PROF_BLOCK && (wid_) == PROF_WAVE) { const unsigned t_ = PROF_NOW(); \
        if ((threadIdx.x & 63) == 0) ((volatile PG8_LAS unsigned*)((lds_) + pg8::EPI_MISC_OFF))[22] = t_; } } while (0)
#define PROF_STOP(n, lds_, wid_) do { if (PROF_ID == (n) && blockIdx.x == PROF_BLOCK && (wid_) == PROF_WAVE) { const unsigned t_ = PROF_NOW(); \
        if ((threadIdx.x & 63) == 0) { volatile PG8_LAS unsigned* m_ = (volatile PG8_LAS unsigned*)((lds_) + pg8::EPI_MISC_OFF); m_[20] = m_[20] + (t_ - m_[22]); } } } while (0)

__device__ __forceinline__ u32x2 mixA_block(const f32x4& gate, const f32x4& chv, const f32x4& prev, const f32x4& w0, const f32x4& w1, const f32x4& w2, const f32x4& cb) {
    f32x4 c1, c2;
#pragma unroll
    for (int j = 0; j < 4; ++j) { c1[j] = shl_prev<1>(chv[j], prev[j]); c2[j] = shl_prev<2>(chv[j], prev[j]); }
    const f32x4 o = gate * (w0 * c2 + w1 * c1 + w2 * chv + cb);
    u32x2 w; w.x = cvt_pk_bf16(o[0], o[1]); w.y = cvt_pk_bf16(o[2], o[3]); return w;
}
__device__ __forceinline__ u32x4 mixB_block(const f32x4 (&cu)[2], const f32x4 (&pu)[2], const f32x4 (&sg)[2], float rc, int w) {
    float o[8];
#pragma unroll
    for (int e = 0; e < 8; ++e) {
        const float uv = cu[e >> 2][e & 3], up = pu[e >> 2][e & 3];
        float s = uv + shl_prev<1>(uv, up);
        if (w >= 4) { float sp = up + shl_zero<1>(up); s += shl_prev<2>(s, sp);
            if (w >= 8) { sp += shl_zero<2>(sp); s += shl_prev<4>(s, sp);
                if (w >= 16) { sp += shl_zero<4>(sp); s += shl_prev<8>(s, sp); } } }
        o[e] = (s * rc - uv) * sg[e >> 2][e & 3];
    }
    u32x4 wv; wv.x = cvt_pk_bf16(o[0], o[1]); wv.y = cvt_pk_bf16(o[2], o[3]); wv.z = cvt_pk_bf16(o[4], o[5]); wv.w = cvt_pk_bf16(o[6], o[7]); return wv;
}
template <int K> __device__ __forceinline__ float shl_zero_fwd(float cur) { return __int_as_float(__builtin_amdgcn_update_dpp(0, __float_as_int(cur), 0x100 + K, 0xf, 0xf, true)); }
template <int K> __device__ __forceinline__ float row_ror(float cur) { return __int_as_float(__builtin_amdgcn_update_dpp(0, __float_as_int(cur), 0x120 + K, 0xf, 0xf, false)); }
template <int W> __device__ __forceinline__ void lead_sums(const f32x4 (&p)[2], f32x4 (&q)[2]) {
#pragma unroll
    for (int e = 0; e < 8; ++e) { float t = p[e >> 2][e & 3]; t += shl_zero_fwd<1>(t); if (W >= 4) t += shl_zero_fwd<2>(t); if (W >= 8) t += shl_zero_fwd<4>(t); if (W >= 16) t += shl_zero_fwd<8>(t); q[e >> 2][e & 3] = t; }
}
template <int W> __device__ __forceinline__ u32x4 mixB_blockT(const f32x4 (&cu)[2], const f32x4 (&pq)[2], const f32x4 (&sg)[2], float rc, float maskf) {
    float o[8];
#pragma unroll
    for (int e = 0; e < 8; ++e) {
        const float uv = cu[e >> 2][e & 3];
        float s = uv + shl_zero<1>(uv); if (W >= 4) s += shl_zero<2>(s); if (W >= 8) s += shl_zero<4>(s); if (W >= 16) s += shl_zero<8>(s);
        s = fmaf(row_ror<W - 1>(pq[e >> 2][e & 3]), maskf, s);
        o[e] = (s * rc - uv) * sg[e >> 2][e & 3];
    }
    u32x4 wv; wv.x = cvt_pk_bf16(o[0], o[1]); wv.y = cvt_pk_bf16(o[2], o[3]); wv.z = cvt_pk_bf16(o[4], o[5]); wv.w = cvt_pk_bf16(o[6], o[7]); return wv;
}
__device__ __forceinline__ void st_sc1_f32x4(float* p, const f32x4& v) {
    __hip_atomic_store((unsigned long long*)p, ((unsigned long long)__float_as_uint(v[1]) << 32) | __float_as_uint(v[0]), __ATOMIC_RELAXED, __HIP_MEMORY_SCOPE_AGENT);
    __hip_atomic_store((unsigned long long*)p + 1, ((unsigned long long)__float_as_uint(v[3]) << 32) | __float_as_uint(v[2]), __ATOMIC_RELAXED, __HIP_MEMORY_SCOPE_AGENT);
}
__device__ __forceinline__ void st_pay_u32x2(void* p, const u32x2& v) {
    *(u32x2*)p = v;
}
__device__ __forceinline__ void st_pay_u32x4(void* p, const u32x4& v) {
    *(u32x4*)p = v;
}
__device__ __forceinline__ void st_pay_f32(float* p, float v) {
    *p = v;
}
__device__ __forceinline__ f32x4 ld_sc1_f32x4(const float* p) {
    const unsigned long long a = __hip_atomic_load((unsigned long long*)p, __ATOMIC_RELAXED, __HIP_MEMORY_SCOPE_AGENT), b = __hip_atomic_load((unsigned long long*)p + 1, __ATOMIC_RELAXED, __HIP_MEMORY_SCOPE_AGENT);
    return (f32x4){__uint_as_float((unsigned)a), __uint_as_float((unsigned)(a >> 32)), __uint_as_float((unsigned)b), __uint_as_float((unsigned)(b >> 32))};
}

template <bool I8> struct EpiMixT {
    static constexpr bool PERM = false, AFTER_DRAIN = false;
    bf16_t* Y; const float* ssqp; const float* convw; const float* convb; const float* pscale;
    float* halo; unsigned* flags; unsigned* tmo; unsigned epoch;
    const float* sa; const float* sw;
    unsigned long long* hga;
    __device__ __forceinline__ void sweepA(const unsigned long long* g, bool active, f32x4& v, const Unit& u, int lane) const {
        for (unsigned sp = 0;;) { bool ok = true;
            if (active) {
#pragma unroll
                for (int k = 0; k < 4; ++k) { const unsigned long long x = __hip_atomic_load((unsigned long long*)g + k, __ATOMIC_RELAXED, __HIP_MEMORY_SCOPE_AGENT); v[k] = __uint_as_float((unsigned)x); ok &= ((unsigned)(x >> 32) == epoch); } }
            if (__all(ok)) return;
            __builtin_amdgcn_s_sleep(2);
            if (++sp > (1u << 20)) { if (lane == 0) __hip_atomic_store(tmo, 0x500u | (unsigned)u.pn, __ATOMIC_RELAXED, __HIP_MEMORY_SCOPE_AGENT); return; } }
    }
    __device__ __forceinline__ void wait_flag(const Unit& u, int lane) const {
        unsigned sp = 0; unsigned* fl = flags + ((u.pm - 1) * 12 + u.pn) * 16; const unsigned want = 4u;
        while ((unsigned)__builtin_amdgcn_readfirstlane(__hip_atomic_load(fl, __ATOMIC_RELAXED, __HIP_MEMORY_SCOPE_AGENT)) < want) { __builtin_amdgcn_s_sleep(1);
            if (++sp > (1u << 20)) { if (lane == 0) __hip_atomic_store(tmo, 0x500u | (unsigned)u.pn, __ATOMIC_RELAXED, __HIP_MEMORY_SCOPE_AGENT); break; } }
    }
    __device__ __forceinline__ u32x4 b_block(int g, const f32x4 (&cu)[2], const f32x4 (&pu)[2], const f32x4 (&sg)[2], float rc, int fr) const {
        f32x4 q[2]; u32x4 r;
        if (g == 0) { lead_sums<2>(pu, q); r = mixB_blockT<2>(cu, q, sg, rc, fr < 1 ? 1.0f : 0.0f); }
        else if (g == 1) { lead_sums<4>(pu, q); r = mixB_blockT<4>(cu, q, sg, rc, fr < 3 ? 1.0f : 0.0f); }
        else if (g == 2) { lead_sums<8>(pu, q); r = mixB_blockT<8>(cu, q, sg, rc, fr < 7 ? 1.0f : 0.0f); }
        else { lead_sums<16>(pu, q); r = mixB_blockT<16>(cu, q, sg, rc, fr < 15 ? 1.0f : 0.0f); }
        return r;
    }
    __device__ __forceinline__ void operator()(f32x4 (&acc)[2][2][4][2], const Unit& u, int wr, int wc, int fr, int fq, PG8_LAS unsigned char* lds, int wid, int lane) const {
        asm volatile("" : "+v"(fr), "+v"(fq), "+v"(lane));
        PROF_START(2, lds, wid);
        PG8_LAS float* HB = (PG8_LAS float*)(lds + EPI_HB_OFF);
        PG8_LAS float* INV = (PG8_LAS float*)(lds + EPI_INV_OFF);
        volatile PG8_LAS unsigned* KEY = (volatile PG8_LAS unsigned*)(lds + EPI_MISC_OFF + 64);
        const unsigned key = (epoch << 16) | (unsigned)u.pm;
        if (KEY[0] != key) {
            int t = threadIdx.x; asm volatile("" : "+v"(t));
            if (t < 256) { const f32x4 p = *(const f32x4*)(ssqp + (size_t)(u.pm * BM + t) * 4); INV[t] = rsqrtf(((p[0] + p[1]) + (p[2] + p[3])) * (1.0f / 1024.0f) + 1e-6f) * (I8 ? sa[(size_t)u.pm * BM + t] : 1.0f); }
            asm volatile("s_waitcnt lgkmcnt(0)" ::: "memory"); __builtin_amdgcn_s_barrier(); asm volatile("" ::: "memory");
            if (t == 0) KEY[0] = key;
        }
        const int rl = wr * 64 + fr, row0 = u.pm * BM + rl;
        const bool need = (u.pm & 31) != 0;
        float* halo_out = halo + (size_t)(u.pn * 64 + u.pm) * HALO_TILE;
        const float* halo_in = halo_out - HALO_TILE;
        unsigned* myflag = flags + (u.pm * 12 + u.pn) * 16;
        float inv[2][4];
#pragma unroll
        for (int ai = 0; ai < 2; ++ai)
#pragma unroll
            for (int m = 0; m < 4; ++m) inv[ai][m] = INV[rl + ai * HALF + m * 16];
        const f32x4 zero = {0.f, 0.f, 0.f, 0.f};
        if constexpr (I8) {
            const float* swp = sw + u.pn * BM + 32 * wc + 4 * fq;
#pragma unroll
            for (int bj = 0; bj < 2; ++bj)
#pragma unroll
                for (int n = 0; n < 2; ++n) { const f32x4 swv = *(const f32x4*)(swp + HALF * bj + 16 * n);
#pragma unroll
                    for (int ai = 0; ai < 2; ++ai)
#pragma unroll
                        for (int m = 0; m < 4; ++m) acc[ai][bj][m][n] = __builtin_convertvector(__builtin_bit_cast(i32x4, acc[ai][bj][m][n]), f32x4) * swv; }
        }
        if (u.pn < 8) {
            const int chl = 16 * wc + 4 * fq, chg = 64 * u.pn + chl;
            const f32x4 w0 = *(const f32x4*)(convw + chg), w1 = *(const f32x4*)(convw + 512 + chg), w2 = *(const f32x4*)(convw + 1024 + chg), cb = *(const f32x4*)(convb + chg);
            unsigned long long* ga = hga + (size_t)(u.pn * 64 + u.pm) * 128 + (fr >= 14 ? (fr - 14) * 64 + chl : 0);
            if (wr == 1 && fr >= 14) { const float s = inv[1][3]; const f32x4 t = (acc[1][0][3][1] * s) * (acc[1][1][3][0] * s);
#pragma unroll
                for (int j = 0; j < 4; ++j) __hip_atomic_store(ga + j, ((unsigned long long)epoch << 32) | __float_as_uint(t[j]), __ATOMIC_RELAXED, __HIP_MEMORY_SCOPE_AGENT); }
#pragma unroll
            for (int ai = 0; ai < 2; ++ai)
#pragma unroll
                for (int m = 0; m < 4; ++m) { const float s = inv[ai][m]; const f32x4 b = acc[ai][0][m][0] * s, c = acc[ai][0][m][1] * s, h = acc[ai][1][m][0] * s, z = acc[ai][1][m][1] * s; f32x4 g;
#pragma unroll
                    for (int j = 0; j < 4; ++j) g[j] = 0.f;
                    acc[ai][0][m][0] = mul_silu4(b, z); acc[ai][0][m][1] = c * h; }
            PROF_STOP(2, lds, wid); PROF_START(3, lds, wid);
            if (fr >= 14) {
                *(PG8_LAS f32x4*)(HB + (wr * 16 + fr) * HBS + chl) = acc[0][0][3][1];
                if (wr == 0) *(PG8_LAS f32x4*)(HB + (32 + fr) * HBS + chl) = acc[1][0][3][1];
            }
            asm volatile("s_waitcnt lgkmcnt(0)" ::: "memory"); __builtin_amdgcn_s_barrier(); asm volatile("" ::: "memory");
            PROF_STOP(3, lds, wid); PROF_START(4, lds, wid);
            u32x2 o[2][4];
            { const f32x4 pv = (fr >= 14) ? *(const PG8_LAS f32x4*)(HB + ((1 + wr) * 16 + fr) * HBS + chl) : zero;
              o[1][0] = mixA_block(acc[1][0][0][0], acc[1][0][0][1], pv, w0, w1, w2, cb); }
#pragma unroll
            for (int m = 1; m < 4; ++m) o[1][m] = mixA_block(acc[1][0][m][0], acc[1][0][m][1], acc[1][0][m - 1][1], w0, w1, w2, cb);
            PROF_STOP(4, lds, wid); PROF_START(5, lds, wid);
            f32x4 pvg = zero;
            if (wr == 1) { if (fr >= 14) pvg = *(const PG8_LAS f32x4*)(HB + fr * HBS + chl); }
            else if (need) sweepA(ga - 128, fr >= 14, pvg, u, lane);
            PROF_STOP(5, lds, wid); PROF_START(6, lds, wid);
#pragma unroll
            for (int m = 1; m < 4; ++m) o[0][m] = mixA_block(acc[0][0][m][0], acc[0][0][m][1], acc[0][0][m - 1][1], w0, w1, w2, cb);
            o[0][0] = mixA_block(acc[0][0][0][0], acc[0][0][0][1], pvg, w0, w1, w2, cb);
            PROF_STOP(6, lds, wid); PROF_START(7, lds, wid);
            bf16_t* yp = Y + (size_t)row0 * 1024 + chg;
#pragma unroll
            for (int ai = 0; ai < 2; ++ai)
#pragma unroll
                for (int m = 0; m < 4; ++m) st_pay_u32x2(yp + (size_t)(ai * HALF + 16 * m) * 1024, o[ai][m]);
            PROF_STOP(7, lds, wid);
        } else {
            const int g = u.pn - 8, dl = 32 * wc + 8 * fq;
            const f32x4 sc0 = *(const f32x4*)(pscale + 128 * g + dl), sc1 = *(const f32x4*)(pscale + 128 * g + dl + 4);
            if (wr == 1) { const float s = inv[1][3]; st_sc1_f32x4(halo_out + fr * 128 + dl, acc[1][0][3][0] * s); st_sc1_f32x4(halo_out + fr * 128 + dl + 4, acc[1][0][3][1] * s); }
#pragma unroll
            for (int ai = 0; ai < 2; ++ai)
#pragma unroll
                for (int m = 0; m < 4; ++m) { const float s = inv[ai][m];
#pragma unroll
                    for (int n = 0; n < 2; ++n) { const f32x4 uu = acc[ai][0][m][n] * s, z = acc[ai][1][m][n] * s; f32x4 sg;
#pragma unroll
                        for (int j = 0; j < 4; ++j) sg[j] = 0.f;
                        acc[ai][0][m][n] = uu; acc[ai][1][m][n] = mul_silu4(n ? sc1 : sc0, z); } }
            PROF_STOP(2, lds, wid); PROF_START(3, lds, wid);
#pragma unroll
            for (int n = 0; n < 2; ++n) {
                *(PG8_LAS f32x4*)(HB + (wr * 16 + fr) * HBS + dl + 4 * n) = acc[0][0][3][n];
                if (wr == 0) *(PG8_LAS f32x4*)(HB + (32 + fr) * HBS + dl + 4 * n) = acc[1][0][3][n];
            }
            asm volatile("s_waitcnt lgkmcnt(0)" ::: "memory"); __builtin_amdgcn_s_barrier(); asm volatile("" ::: "memory");
            if (wr == 1) { asm volatile("s_waitcnt vmcnt(0)" ::: "memory"); if (lane == 0) __hip_atomic_fetch_add(myflag, 1u, __ATOMIC_RELAXED, __HIP_MEMORY_SCOPE_AGENT); }
            const int tpos0 = (u.pm * BM + rl) & 8191;
            const float fw = (float)(2 << g);
#define MIXB_RC(ai, m) (need ? (1.0f / fw) : 1.0f / fminf((float)(tpos0 + (ai) * HALF + (m) * 16 + 1), fw))
            PROF_STOP(3, lds, wid); PROF_START(4, lds, wid);
            u32x4 o[2][4];
            { f32x4 pv[2]; pv[0] = *(const PG8_LAS f32x4*)(HB + ((1 + wr) * 16 + fr) * HBS + dl); pv[1] = *(const PG8_LAS f32x4*)(HB + ((1 + wr) * 16 + fr) * HBS + dl + 4);
              o[1][0] = b_block(g, acc[1][0][0], pv, acc[1][1][0], MIXB_RC(1, 0), fr); }
#pragma unroll
            for (int m = 1; m < 4; ++m) o[1][m] = b_block(g, acc[1][0][m], acc[1][0][m - 1], acc[1][1][m], MIXB_RC(1, m), fr);
            PROF_STOP(4, lds, wid); PROF_START(5, lds, wid);
            f32x4 pvg[2]; pvg[0] = zero; pvg[1] = zero;
            if (wr == 1) { pvg[0] = *(const PG8_LAS f32x4*)(HB + fr * HBS + dl); pvg[1] = *(const PG8_LAS f32x4*)(HB + fr * HBS + dl + 4); }
            else if (need) { wait_flag(u, lane); pvg[0] = ld_sc1_f32x4(halo_in + fr * 128 + dl); pvg[1] = ld_sc1_f32x4(halo_in + fr * 128 + dl + 4); }
            PROF_STOP(5, lds, wid); PROF_START(6, lds, wid);
#pragma unroll
            for (int m = 1; m < 4; ++m) o[0][m] = b_block(g, acc[0][0][m], acc[0][0][m - 1], acc[0][1][m], MIXB_RC(0, m), fr);
            o[0][0] = b_block(g, acc[0][0][0], pvg, acc[0][1][0], MIXB_RC(0, 0), fr);
#undef MIXB_RC
            PROF_STOP(6, lds, wid); PROF_START(7, lds, wid);
            bf16_t* yp = Y + (size_t)row0 * 1024 + 512 + 128 * g + dl;
#pragma unroll
            for (int ai = 0; ai < 2; ++ai)
#pragma unroll
                for (int m = 0; m < 4; ++m) st_pay_u32x4(yp + (size_t)(ai * HALF + 16 * m) * 1024, o[ai][m]);
            PROF_STOP(7, lds, wid);
        }
    }
};

template <int MODE> struct EpiRms {
    static constexpr bool PERM = true, AFTER_DRAIN = true;
    const bf16_t* base_b; float* out_f; bf16_t* out_b; float* ssq_out; const float* gpost;
    unsigned long long* xslot; unsigned* tmo; unsigned tag;
    unsigned long long* xslot2; float* sa_out; signed char* xq;
    __device__ __forceinline__ void fused(f32x4 (&acc)[2][2][4][2], const Unit& u, int wr, int wc, int fr, int fq, PG8_LAS unsigned char* lds, int wid, int lane) const {
        PG8_LAS float* P = (PG8_LAS float*)lds;
        PG8_LAS float* S = (PG8_LAS float*)(lds + 4096);
        PG8_LAS float* PM = (PG8_LAS float*)(lds + 8192);
        PG8_LAS float* S2 = (PG8_LAS float*)(lds + 12288);
        PROF_START(30, lds, wid);
#pragma unroll
        for (int ai = 0; ai < 2; ++ai)
#pragma unroll
            for (int m = 0; m < 4; ++m) { float s = 0.f;
#pragma unroll
                for (int bj = 0; bj < 2; ++bj)
#pragma unroll
                    for (int n = 0; n < 2; ++n) { const f32x4 x = acc[ai][bj][m][n]; s += (x[0] * x[0] + x[1] * x[1]) + (x[2] * x[2] + x[3] * x[3]); }
                s += __shfl_xor(s, 16); s += __shfl_xor(s, 32);
                if (fq == 0) P[(ai * HALF + wr * 64 + m * 16 + fr) * 4 + wc] = s; }
        asm volatile("s_waitcnt lgkmcnt(0)" ::: "memory"); __builtin_amdgcn_s_barrier(); asm volatile("" ::: "memory");
        PROF_STOP(30, lds, wid); PROF_START(31, lds, wid);
        const int row = wid * 32 + (lane & 31);
        unsigned long long* slot = xslot + (size_t)(u.pm * BM + row) * 4;
        if (lane < 32) { const f32x4 p = *(const PG8_LAS f32x4*)(P + row * 4); const float t = (p[0] + p[1]) + (p[2] + p[3]);
            __hip_atomic_store(slot + u.pn, ((unsigned long long)tag << 32) | __float_as_uint(t), __ATOMIC_RELAXED, __HIP_MEMORY_SCOPE_AGENT); }
        const int col0 = u.pn * BM + wc * 32 + 8 * fq;
        const size_t off0 = (size_t)(u.pm * BM + wr * 64 + fr) * 1024 + col0;
        u32x4 rb[2][4][2];
#define RMS_LOAD_RES(ai) do { _Pragma("unroll") for (int m = 0; m < 4; ++m) _Pragma("unroll") for (int bj = 0; bj < 2; ++bj) \
            rb[ai][m][bj] = *(const u32x4*)(base_b + off0 + (size_t)((ai) * HALF + m * 16) * 1024 + bj * HALF); } while (0)
        RMS_LOAD_RES(0);
        f32x4 gv[2][2];
#pragma unroll
        for (int bj = 0; bj < 2; ++bj)
#pragma unroll
            for (int n = 0; n < 2; ++n) gv[bj][n] = *(const f32x4*)(gpost + col0 + bj * HALF + 4 * n);
        PROF_STOP(31, lds, wid); PROF_START(32, lds, wid);
        if (lane < 32) { float t = 0.f; unsigned sp = 0;
            for (;;) { bool ok = true; t = 0.f;
#pragma unroll
                for (int k = 0; k < 4; ++k) { const unsigned long long g = __hip_atomic_load(slot + k, __ATOMIC_RELAXED, __HIP_MEMORY_SCOPE_AGENT); ok &= ((unsigned)(g >> 32) == tag); t += __uint_as_float((unsigned)g); }
                if (ok) break;
                __builtin_amdgcn_s_sleep(1);
                if (++sp > (1u << 20)) { __hip_atomic_store(tmo, 0x700u | (unsigned)u.pm, __ATOMIC_RELAXED, __HIP_MEMORY_SCOPE_AGENT); break; } }
            S[row] = rsqrtf(t * (1.0f / 1024.0f) + 1e-6f); }
        asm volatile("s_waitcnt lgkmcnt(0)" ::: "memory"); __builtin_amdgcn_s_barrier(); asm volatile("" ::: "memory");
        PROF_STOP(32, lds, wid); PROF_START(33, lds, wid);
        RMS_LOAD_RES(1);
#undef RMS_LOAD_RES
        asm volatile("" ::: "memory");
#pragma unroll
        for (int ai = 0; ai < 2; ++ai)
#pragma unroll
            for (int m = 0; m < 4; ++m) { const int r = ai * HALF + wr * 64 + m * 16 + fr; const float iv = S[r]; const size_t off = off0 + (size_t)(ai * HALF + m * 16) * 1024; float q = 0.f, mx = 0.f;
#pragma unroll
                for (int bj = 0; bj < 2; ++bj) { const u32x4 bb = rb[ai][m][bj];
                    f32x4 b0, b1; b0[0] = __uint_as_float(bb.x << 16); b0[1] = __uint_as_float(bb.x & 0xffff0000u); b0[2] = __uint_as_float(bb.y << 16); b0[3] = __uint_as_float(bb.y & 0xffff0000u);
                    b1[0] = __uint_as_float(bb.z << 16); b1[1] = __uint_as_float(bb.z & 0xffff0000u); b1[2] = __uint_as_float(bb.w << 16); b1[3] = __uint_as_float(bb.w & 0xffff0000u);
                    const f32x4 o0 = b0 + acc[ai][bj][m][0] * iv * gv[bj][0], o1 = b1 + acc[ai][bj][m][1] * iv * gv[bj][1];
                    if (MODE == 0) { q += ((o0[0] * o0[0] + o0[1] * o0[1]) + (o0[2] * o0[2] + o0[3] * o0[3])) + ((o1[0] * o1[0] + o1[1] * o1[1]) + (o1[2] * o1[2] + o1[3] * o1[3]));
                        mx = fmaxf(mx, fmaxf(fmaxf(fmaxf(fabsf(o0[0]), fabsf(o0[1])), fmaxf(fabsf(o0[2]), fabsf(o0[3]))), fmaxf(fmaxf(fabsf(o1[0]), fabsf(o1[1])), fmaxf(fabsf(o1[2]), fabsf(o1[3])))));
                        u32x4 wv; wv.x = cvt_pk_bf16(o0[0], o0[1]); wv.y = cvt_pk_bf16(o0[2], o0[3]); wv.z = cvt_pk_bf16(o1[0], o1[1]); wv.w = cvt_pk_bf16(o1[2], o1[3]); st_pay_u32x4(out_b + off + bj * HALF, wv); }
                    else { __builtin_nontemporal_store(o0, (f32x4*)(out_f + off + bj * HALF)); __builtin_nontemporal_store(o1, (f32x4*)(out_f + off + bj * HALF + 4)); } }
                if (MODE == 0) { q += __shfl_xor(q, 16); q += __shfl_xor(q, 32); mx = fmaxf(mx, __shfl_xor(mx, 16)); mx = fmaxf(mx, __shfl_xor(mx, 32)); if (fq == 0) { P[r * 4 + wc] = q; PM[r * 4 + wc] = mx; } } }
        PROF_STOP(33, lds, wid); PROF_START(34, lds, wid);
        if (MODE == 0) {
            asm volatile("s_waitcnt lgkmcnt(0)" ::: "memory"); __builtin_amdgcn_s_barrier(); asm volatile("" ::: "memory");
            if (lane < 32) { const f32x4 p = *(const PG8_LAS f32x4*)(P + row * 4); st_pay_f32(ssq_out + (size_t)(u.pm * BM + row) * 4 + u.pn, (p[0] + p[1]) + (p[2] + p[3])); }
            unsigned long long* slot2 = xslot2 + (size_t)(u.pm * BM + row) * 4;
            if (lane < 32) { const f32x4 pm4 = *(const PG8_LAS f32x4*)(PM + row * 4);
                __hip_atomic_store(slot2 + u.pn, ((unsigned long long)tag << 32) | __float_as_uint(fmaxf(fmaxf(pm4[0], pm4[1]), fmaxf(pm4[2], pm4[3]))), __ATOMIC_RELAXED, __HIP_MEMORY_SCOPE_AGENT);
                float rmx = 0.f; unsigned sp = 0;
                for (;;) { bool ok = true; rmx = 0.f;
#pragma unroll
                    for (int k = 0; k < 4; ++k) { const unsigned long long g = __hip_atomic_load(slot2 + k, __ATOMIC_RELAXED, __HIP_MEMORY_SCOPE_AGENT); ok &= ((unsigned)(g >> 32) == tag); rmx = fmaxf(rmx, __uint_as_float((unsigned)g)); }
                    if (ok) break;
                    __builtin_amdgcn_s_sleep(1);
                    if (++sp > (1u << 20)) { __hip_atomic_store(tmo, 0x780u | (unsigned)u.pm, __ATOMIC_RELAXED, __HIP_MEMORY_SCOPE_AGENT); break; } }
                rmx = fmaxf(rmx, 1e-30f); S2[row] = 127.0f / rmx;
                if (u.pn == 0) st_pay_f32(sa_out + (size_t)u.pm * BM + row, rmx * (1.0f / 127.0f)); }
            asm volatile("s_waitcnt vmcnt(0) lgkmcnt(0)" ::: "memory"); __builtin_amdgcn_s_barrier(); asm volatile("" ::: "memory");
#pragma unroll
            for (int ai = 0; ai < 2; ++ai)
#pragma unroll
                for (int m = 0; m < 4; ++m) { const int r = ai * HALF + wr * 64 + m * 16 + fr; const float qs = S2[r]; const size_t off = off0 + (size_t)(ai * HALF + m * 16) * 1024;
#pragma unroll
                    for (int bj = 0; bj < 2; ++bj) { const u32x4 bb = *(const u32x4*)(out_b + off + bj * HALF); const unsigned w4[4] = {bb.x, bb.y, bb.z, bb.w}; u32x2 o;
#pragma unroll
                        for (int i = 0; i < 2; ++i) { unsigned rr = 0u;
#pragma unroll
                            for (int j = 0; j < 2; ++j) { const unsigned ww = w4[2 * i + j]; const int ql = max(-127, min(127, (int)rintf(__uint_as_float(ww << 16) * qs))), qh = max(-127, min(127, (int)rintf(__uint_as_float(ww & 0xffff0000u) * qs)));
                                rr |= ((unsigned)(ql & 0xff) | ((unsigned)(qh & 0xff) << 8)) << (16 * j); }
                            if (i == 0) o.x = rr; else o.y = rr; }
                        st_pay_u32x2(xq + off + bj * HALF, o); } }
        }
    }
};

template <class Epi, class Sched, bool ALIGN_EPI = false, bool SP2 = false, bool I8 = false>
__device__ __forceinline__ void gemm_phase(PG8_LAS unsigned char* lds, const Gemm g, const Sched& S, const Epi& E) {
    const int tid = threadIdx.x, wid = __builtin_amdgcn_readfirstlane(tid >> 6), lane = tid & 63, wr = wid >> 2, wc = wid & 3, fr = lane & 15, fq = lane >> 4;
    const int K = g.K, nt = K / BK;
    unsigned voffA[2], voffB[2];
#pragma unroll
    for (int i = 0; i < 2; ++i) { int R, C; stage_rc(tid * 16 + i * 8192, R, C); const int Rb = Epi::PERM ? ((R & ~31) + perm32(R & 31)) : R;
        voffA[i] = (unsigned)(R * K + C) * 2u; voffB[i] = (unsigned)(Rb * K + C) * 2u; }
    const size_t kstep = (size_t)(BK * 2);
    const size_t hstep = (size_t)HALF * K * 2;
    const size_t tstep = 2 * hstep;
    const unsigned ldsw = (unsigned)wid * 1024u;
    const int aoff = lds_byte(wr * 64 + fr, fq * 8), boff = lds_byte(wc * 32 + fr, fq * 8);
#define PG8_SA(b, h) (((b) * 2 + (h)) * HTB)
#define PG8_SB(b, h) ((4 + (b) * 2 + (h)) * HTB)
#define PG8_STAGE(bufoff, gbase, voff) do { _Pragma("unroll") for (int _i = 0; _i < 2; ++_i) \
        __builtin_amdgcn_global_load_lds((const unsigned*)((const char*)(gbase) + (voff)[_i]), (PG8_LAS unsigned*)(lds + (bufoff) + ldsw + _i * 8192), 16, 0, 0); } while (0)
#define PG8_LDA(dst, b, h) do { _Pragma("unroll") for (int m = 0; m < 4; ++m) _Pragma("unroll") for (int k = 0; k < 2; ++k) dst[m][k] = *(const PG8_LAS bf16x8*)(lds + PG8_SA(b, h) + aoff + m * 2048 + k * 1024); } while (0)
#define PG8_LDB(dst, b, h) do { _Pragma("unroll") for (int n = 0; n < 2; ++n) _Pragma("unroll") for (int k = 0; k < 2; ++k) dst[n][k] = *(const PG8_LAS bf16x8*)(lds + PG8_SB(b, h) + boff + n * 2048 + k * 1024); } while (0)
#define PG8_MMA(ai, bj, At, Bt) do { __builtin_amdgcn_s_setprio(1); _Pragma("unroll") for (int m = 0; m < 4; ++m) _Pragma("unroll") for (int n = 0; n < 2; ++n) _Pragma("unroll") for (int k = 0; k < 2; ++k) \
        { if constexpr (I8) acc[ai][bj][m][n] = __builtin_bit_cast(f32x4, __builtin_amdgcn_mfma_i32_16x16x64_i8(__builtin_bit_cast(i32x4, Bt[n][k]), __builtin_bit_cast(i32x4, At[m][k]), __builtin_bit_cast(i32x4, acc[ai][bj][m][n]), 0, 0, 0)); \
          else acc[ai][bj][m][n] = __builtin_amdgcn_mfma_f32_16x16x32_bf16(Bt[n][k], At[m][k], acc[ai][bj][m][n], 0, 0, 0); } __builtin_amdgcn_s_setprio(0); } while (0)
#define PG8_WAIT_V(n) asm volatile("s_waitcnt vmcnt(" #n ")" ::: "memory")
#define PG8_WAIT_L(n) asm volatile("s_waitcnt lgkmcnt(" #n ")" ::: "memory")
#define PG8_BAR __builtin_amdgcn_s_barrier()
#define PG8_SCHED __builtin_amdgcn_sched_barrier(0)
    PROF_START(22, lds, wid);
    Unit cur, nxt; int ui = 0;
    if (!S.next(0, cur)) return;
    f32x4 acc[2][2][4][2];
#pragma unroll
    for (int a = 0; a < 2; ++a)
#pragma unroll
        for (int b = 0; b < 2; ++b)
#pragma unroll
            for (int m = 0; m < 4; ++m)
#pragma unroll
                for (int n = 0; n < 2; ++n) acc[a][b][m][n] = (f32x4){0.f, 0.f, 0.f, 0.f};
    bf16x8 At[4][2], B0[2][2], B1[2][2];
    const char* cA = (const char*)g.A + (size_t)cur.pm * tstep; const char* cB = (const char*)g.Bt + (size_t)cur.pn * tstep;
    S.a_ready(cur);
    if constexpr (SP2) {
        PG8_STAGE(PG8_SB(0, 0), cB, voffB); PG8_STAGE(PG8_SB(0, 1), cB + hstep, voffB); PG8_STAGE(PG8_SA(0, 0), cA, voffA); PG8_STAGE(PG8_SA(0, 1), cA + hstep, voffA);
        if (wr == 1) PG8_BAR;
        PG8_WAIT_V(2); PG8_BAR;
        PG8_STAGE(PG8_SB(1, 0), cB + kstep, voffB); PG8_STAGE(PG8_SA(1, 0), cA + kstep, voffA); PG8_STAGE(PG8_SB(1, 1), cB + hstep + kstep, voffB);
        PG8_WAIT_V(6); PG8_BAR;
    } else {
        PG8_STAGE(PG8_SB(0, 0), cB, voffB); PG8_STAGE(PG8_SA(0, 0), cA, voffA); PG8_STAGE(PG8_SB(0, 1), cB + hstep, voffB); PG8_STAGE(PG8_SA(0, 1), cA + hstep, voffA);
        if (wr == 1) PG8_BAR;
        PG8_WAIT_V(4); PG8_BAR;
        PG8_STAGE(PG8_SB(1, 0), cB + kstep, voffB); PG8_STAGE(PG8_SA(1, 0), cA + kstep, voffA); PG8_STAGE(PG8_SB(1, 1), cB + hstep + kstep, voffB);
        PG8_WAIT_V(6); PG8_BAR;
    }
    PROF_STOP(22, lds, wid);
    for (;;) {
        const bool has_next = S.next(ui + 1, nxt);
        const char* nA = has_next ? (const char*)g.A + (size_t)nxt.pm * tstep : cA; const char* nB = has_next ? (const char*)g.Bt + (size_t)nxt.pn * tstep : cB;
        PROF_START(8, lds, wid);
        asm volatile(".p2align 8");
        for (int t = 0; t < nt; t += 2) {
            const bool last = (t == nt - 2);
            const char* a1 = cA + (size_t)(t + 1) * kstep;
            const char* a2 = last ? nA : cA + (size_t)(t + 2) * kstep; const char* b2 = last ? nB : cB + (size_t)(t + 2) * kstep;
            const char* a3 = a2 + kstep; const char* b3 = b2 + kstep;
            if (last && has_next) S.a_ready(nxt);
            if constexpr (SP2) {
            PG8_LDB(B0, 0, 0); PG8_LDB(B1, 0, 1); PG8_SCHED; PG8_LDA(At, 0, 0); PG8_STAGE(PG8_SA(1, 1), a1 + hstep, voffA);
            PG8_WAIT_V(8); PG8_WAIT_L(0); PG8_BAR; PG8_MMA(0, 0, At, B0); PG8_MMA(0, 1, At, B1); PG8_BAR; PG8_SCHED;
            PG8_LDA(At, 0, 1); PG8_STAGE(PG8_SB(0, 0), b2, voffB); PG8_STAGE(PG8_SB(0, 1), b2 + hstep, voffB); PG8_STAGE(PG8_SA(0, 0), a2, voffA);
            PG8_WAIT_V(8); PG8_WAIT_L(0); PG8_BAR; PG8_MMA(1, 0, At, B0); PG8_MMA(1, 1, At, B1); PG8_BAR; PG8_SCHED;
            PG8_LDB(B0, 1, 0); PG8_LDB(B1, 1, 1); PG8_SCHED; PG8_LDA(At, 1, 0); PG8_STAGE(PG8_SA(0, 1), a2 + hstep, voffA);
            PG8_WAIT_V(8); PG8_WAIT_L(0); PG8_BAR; PG8_MMA(0, 0, At, B0); PG8_MMA(0, 1, At, B1); PG8_BAR; PG8_SCHED;
            PG8_LDA(At, 1, 1); PG8_STAGE(PG8_SB(1, 0), b3, voffB); PG8_STAGE(PG8_SB(1, 1), b3 + hstep, voffB); PG8_STAGE(PG8_SA(1, 0), a3, voffA);
            PG8_WAIT_V(8); PG8_WAIT_L(0); PG8_BAR; PG8_MMA(1, 0, At, B0); PG8_MMA(1, 1, At, B1); PG8_BAR; PG8_SCHED;
            } else {
            PG8_LDB(B0, 0, 0); PG8_SCHED; PG8_LDA(At, 0, 0); PG8_STAGE(PG8_SA(1, 1), a1 + hstep, voffA);
            PG8_WAIT_L(8); PG8_BAR; PG8_WAIT_L(0); PG8_MMA(0, 0, At, B0); PG8_BAR; PG8_SCHED;
            PG8_LDB(B1, 0, 1); PG8_STAGE(PG8_SB(0, 0), b2, voffB);
            PG8_BAR; PG8_WAIT_L(0); PG8_MMA(0, 1, At, B1); PG8_BAR;
            PG8_LDA(At, 0, 1); PG8_STAGE(PG8_SA(0, 0), a2, voffA);
            PG8_BAR; PG8_WAIT_L(0); PG8_MMA(1, 0, At, B0); PG8_BAR; PG8_SCHED;
            PG8_STAGE(PG8_SB(0, 1), b2 + hstep, voffB);
            PG8_WAIT_V(6); PG8_BAR; PG8_MMA(1, 1, At, B1); PG8_BAR;
            PG8_LDB(B0, 1, 0); PG8_SCHED; PG8_LDA(At, 1, 0); PG8_STAGE(PG8_SA(0, 1), a2 + hstep, voffA);
            PG8_WAIT_L(8); PG8_BAR; PG8_WAIT_L(0); PG8_MMA(0, 0, At, B0); PG8_BAR; PG8_SCHED;
            PG8_LDB(B1, 1, 1); PG8_STAGE(PG8_SB(1, 0), b3, voffB);
            PG8_BAR; PG8_WAIT_L(0); PG8_MMA(0, 1, At, B1); PG8_BAR;
            PG8_LDA(At, 1, 1); PG8_STAGE(PG8_SA(1, 0), a3, voffA);
            PG8_BAR; PG8_WAIT_L(0); PG8_MMA(1, 0, At, B0); PG8_BAR; PG8_SCHED;
            PG8_STAGE(PG8_SB(1, 1), b3 + hstep, voffB);
            PG8_WAIT_V(6); PG8_BAR; PG8_MMA(1, 1, At, B1); PG8_BAR;
            }
        }
        PROF_STOP(8, lds, wid); PROF_START(14, lds, wid);
        if constexpr (ALIGN_EPI) { if (wr == 0) PG8_BAR; }
        PROF_STOP(14, lds, wid); PROF_START(1, lds, wid);
        if constexpr (!Epi::AFTER_DRAIN) { E(acc, cur, wr, wc, fr, fq, lds, wid, lane); S.done(cur); }
        PROF_STOP(1, lds, wid);
        if (!has_next) break;
#pragma unroll
        for (int a = 0; a < 2; ++a)
#pragma unroll
            for (int b = 0; b < 2; ++b)
#pragma unroll
                for (int m = 0; m < 4; ++m)
#pragma unroll
                    for (int n = 0; n < 2; ++n) acc[a][b][m][n] = (f32x4){0.f, 0.f, 0.f, 0.f};
        cur = nxt; cA = nA; cB = nB; ++ui;
        if constexpr (ALIGN_EPI) { if (wr == 1) PG8_BAR; }
    }
    PROF_START(23, lds, wid);
    PG8_WAIT_V(0);
    if constexpr (!ALIGN_EPI) { if (wr == 0) PG8_BAR; }
    PG8_BAR;
    PROF_STOP(23, lds, wid); PROF_START(11, lds, wid);
    if constexpr (Epi::AFTER_DRAIN) { E.fused(acc, cur, wr, wc, fr, fq, lds, wid, lane); S.done(cur); }
    PROF_STOP(11, lds, wid);
#undef PG8_SA
#undef PG8_SB
#undef PG8_STAGE
#undef PG8_LDA
#undef PG8_LDB
#undef PG8_MMA
#undef PG8_WAIT_V
#undef PG8_WAIT_L
#undef PG8_BAR
#undef PG8_SCHED
}
}

constexpr int NWAVES = 8;
#ifndef MK_N_LAUNCHES
#define MK_N_LAUNCHES 1
#endif
constexpr int N_LAUNCHES = MK_N_LAUNCHES;
constexpr int N_PHASES = 5;

constexpr int D = 1024, BATCH = 2, SEQ = 8192, DEPTH = 2, M = BATCH * SEQ, NIN = 3072;
constexpr size_t MiB = 1u << 20;
constexpr size_t WS_CTL = 0, CTL_ZERO_BYTES = 192 * 1024;
constexpr size_t WS_W1T = 2 * MiB;
constexpr size_t WS_W2T = 14 * MiB;
constexpr size_t WS_SSQ = 18 * MiB;
constexpr size_t WS_XSLOT = 19 * MiB;
constexpr size_t WS_HALO = 20 * MiB;
constexpr size_t WS_XB = 32 * MiB;
constexpr size_t WS_Y = 64 * MiB;
constexpr size_t WS_HGA = 96 * MiB;
constexpr size_t WS_W1Q = 97 * MiB;
constexpr size_t WS_SW = 100 * MiB;
constexpr size_t WS_XQ = 101 * MiB;
constexpr size_t WS_SA = 117 * MiB;
constexpr size_t WS_XS2 = 118 * MiB;
constexpr size_t WS_END = 119 * MiB;
constexpr int CW_TMO = 0, CW_BAR = 4096, CW_CNT = 8192, CW_XCC = 12288, CW_FLAG = 16384, CW_CMAX = 40960  , CW_QCNT = 44160  ;
static_assert(CW_FLAG + 2 * 768 * 16 <= CW_CMAX && (CW_QCNT + 64) * 4 <= (int)CTL_ZERO_BYTES && (CW_FLAG + 2 * 768 * 16) * 4 <= (int)CTL_ZERO_BYTES, "ctl words inside the memset region");

constexpr int RING_BYTES = 131072;
constexpr int HB_OFF = RING_BYTES;
constexpr int MISC_OFF = pg8::EPI_MISC_OFF;
constexpr int LDS_BYTES = pg8::EPI_LDS_END;
constexpr int SCR_STRIDE = 17408;
static_assert(pg8::HB_BYTES <= 25600 && 8 * SCR_STRIDE <= MISC_OFF && LDS_BYTES <= 160 * 1024, "LDS map");

#define GAS __attribute__((address_space(1)))
#define LAS __attribute__((address_space(3)))
typedef unsigned short bf16;
typedef unsigned v4u __attribute__((ext_vector_type(4)));
typedef unsigned v2u __attribute__((ext_vector_type(2)));
typedef float f32x4 __attribute__((ext_vector_type(4)));
typedef float f32x16 __attribute__((ext_vector_type(16)));
#define LDS_WAIT() asm volatile("s_waitcnt lgkmcnt(0)" ::: "memory")
#define VM_WAIT() asm volatile("s_waitcnt vmcnt(0)" ::: "memory")
__device__ __forceinline__ unsigned f2bf(float f) { unsigned u = __builtin_bit_cast(unsigned, f); return (u + 0x7fffu + ((u >> 16) & 1u)) >> 16; }
__device__ __forceinline__ unsigned pk2(float lo, float hi) { return f2bf(lo) | (f2bf(hi) << 16); }

#define XB_TMO      128
#define XB_XCNT(j)  (256  + 64 * (j))
#define XB_XSUB(j)  (1280 + 64 * (j))
#define XB_XGEN(j)  (2304 + 64 * (j))
#define XB_TOP      3328
#define XB_TOPGEN   3392
#define XCD_BAR_WORDS 3456
#define XB_SPIN_CAP (1u << 18)

__device__ __forceinline__ unsigned xb_ld(unsigned* p)              { return __hip_atomic_load(p, __ATOMIC_RELAXED, __HIP_MEMORY_SCOPE_AGENT); }
__device__ __forceinline__ unsigned xb_add(unsigned* p, unsigned v) { return __hip_atomic_fetch_add(p, v, __ATOMIC_RELAXED, __HIP_MEMORY_SCOPE_AGENT); }
__device__ __forceinline__ unsigned xb_xcc_id() { return (unsigned)__builtin_amdgcn_s_getreg((3 << 11) | 20) & 0xFu; }
#define XB_SPIN(cond, bar) do { unsigned _sp = 0; while (cond) { __builtin_amdgcn_s_sleep(1); \
    if ((++_sp & 255u) == 0u) { if (xb_ld(&(bar)[XB_TMO])) break; if (_sp > XB_SPIN_CAP) { atomicAdd(&(bar)[XB_TMO], 1u); break; } } } } while (0)

struct XcdBarrier {
    unsigned* bar; unsigned x;
    volatile LAS unsigned* st;
};

__device__ __forceinline__ XcdBarrier xcd_barrier_post(unsigned* bar, volatile LAS unsigned* st) {
    XcdBarrier b; b.bar = bar; b.x = xb_xcc_id(); b.st = st;
    if (threadIdx.x == 0) (void)xb_add(&bar[XB_XCNT(b.x)], 1u);
    return b;
}
__device__ __forceinline__ void xcd_barrier_complete(unsigned* bar, unsigned x, unsigned& nloc, unsigned& nx) {
    const unsigned G = gridDim.x * gridDim.y * gridDim.z;
    unsigned sum, cnt, mine, sp = 0u;
    for (;;) {
        sum = 0u; cnt = 0u; mine = 0u;
#pragma unroll
        for (unsigned j = 0; j < 16; ++j) { const unsigned c = xb_ld(&bar[XB_XCNT(j)]); sum += c; cnt += (c > 0u) ? 1u : 0u; mine = (j == x) ? c : mine; }
        if (sum == G) break;
        __builtin_amdgcn_s_sleep(1);
        if ((++sp & 255u) == 0u) { if (xb_ld(&bar[XB_TMO])) break; if (sp > XB_SPIN_CAP) { atomicAdd(&bar[XB_TMO], 1u); break; } }
    }
    nloc = mine > 0u ? mine : 1u; nx = cnt > 0u ? cnt : 1u;
}

__device__ __forceinline__ void xcd_barrier(const XcdBarrier& b, bool leader_wb = true, bool self_wb = false) {
    asm volatile("s_waitcnt vmcnt(0)" ::: "memory");
    __syncthreads();
    if (threadIdx.x == 0) {
        unsigned* bar = b.bar;
        if (self_wb) { __builtin_amdgcn_fence(__ATOMIC_RELEASE, "agent"); asm volatile("s_waitcnt vmcnt(0)" ::: "memory"); }
        __builtin_amdgcn_s_waitcnt(0);
        unsigned nloc = b.st[0], nx = b.st[1];
        if (nloc == 0u) { xcd_barrier_complete(bar, b.x, nloc, nx); b.st[0] = nloc; b.st[1] = nx; }
        const unsigned old = xb_add(&bar[XB_XSUB(b.x)], 1u);
        const unsigned gen = old / nloc;
        if (old + 1u == (gen + 1u) * nloc) {
            if (leader_wb) __builtin_amdgcn_fence(__ATOMIC_RELEASE, "agent");
            asm volatile("s_waitcnt vmcnt(0)" ::: "memory");
            const unsigned og = xb_add(&bar[XB_TOP], 1u);
            const unsigned tg = og / nx;
            if (og + 1u == (tg + 1u) * nx) xb_add(&bar[XB_TOPGEN], 1u);
            else XB_SPIN(xb_ld(&bar[XB_TOPGEN]) == tg, bar);
            __builtin_amdgcn_fence(__ATOMIC_ACQUIRE, "agent");
            xb_add(&bar[XB_XGEN(b.x)], 1u);
            asm volatile("s_waitcnt vmcnt(0)" ::: "memory");
        } else {
            XB_SPIN(xb_ld(&bar[XB_XGEN(b.x)]) == gen, bar);
            __builtin_amdgcn_fence(__ATOMIC_ACQUIRE, "agent");
            asm volatile("s_waitcnt vmcnt(0)" ::: "memory");
        }
    }
    __syncthreads();
}


__device__ __forceinline__ void seam_arrive(unsigned* word, bool fence) {
    asm volatile("s_waitcnt vmcnt(0)" ::: "memory");
    __syncthreads();
    if (threadIdx.x == 0) {
        if (fence) { __builtin_amdgcn_fence(__ATOMIC_RELEASE, "agent"); asm volatile("s_waitcnt vmcnt(0)" ::: "memory"); }
        (void)__hip_atomic_fetch_add(word, 1u, __ATOMIC_RELAXED, __HIP_MEMORY_SCOPE_AGENT);
    }
}
__device__ __forceinline__ void seam_wait(unsigned* word, unsigned want, unsigned* tmo, unsigned code) {
    if (threadIdx.x < 64) { unsigned sp = 0;
        __builtin_amdgcn_fence(__ATOMIC_ACQUIRE, "agent");
        while ((unsigned)__builtin_amdgcn_readfirstlane(__hip_atomic_load(word, __ATOMIC_RELAXED, __HIP_MEMORY_SCOPE_AGENT)) < want) { __builtin_amdgcn_s_sleep(1);
            if (++sp > (1u << 20)) { if (threadIdx.x == 0) __hip_atomic_store(tmo, code, __ATOMIC_RELAXED, __HIP_MEMORY_SCOPE_AGENT); break; } }
        asm volatile("s_waitcnt vmcnt(0)" ::: "memory"); }
    __syncthreads();
}

__device__ __forceinline__ float wave_sum(float v) {
#pragma unroll
    for (int o = 1; o < 64; o <<= 1) v += __shfl_xor(v, o);
    return v;
}
__device__ __forceinline__ int w1_srccol(int n) {
    const int pn = n >> 8, c = n & 255, bj = c >> 7, wc = (c >> 5) & 3, nn = (c >> 4) & 1, fq = (c >> 2) & 3, j = c & 3;
    if (pn < 8) return (2 * bj + nn) * 512 + 64 * pn + 16 * wc + 4 * fq + j;
    if (bj == 0) return -1;
    return 2560 + 128 * (pn - 8) + 32 * wc + 8 * fq + 4 * nn + j;
}
struct TrItem { const float* W; const float* gs; bf16* WT; unsigned* cmax; int ldw, n0, srccol, k0; };
__device__ __forceinline__ void tr_load(const TrItem& d, int lane, float (&v)[32]) {
#pragma unroll
    for (int i = 0; i < 32; ++i) v[i] = __builtin_nontemporal_load(d.W + (size_t)(d.k0 + 2 * i + (lane >> 5)) * d.ldw + d.srccol);
}
__device__ __forceinline__ void tr_finish(const TrItem& d, const float (&v)[32], LAS float* scr, int lane) {
    const int c = lane & 7;
    f32x4 g0 = {1.f, 1.f, 1.f, 1.f}, g1 = g0;
    if (d.gs) { g0 = *(const f32x4*)(d.gs + d.k0 + 8 * c); g1 = *(const f32x4*)(d.gs + d.k0 + 8 * c + 4); }
#pragma unroll
    for (int i = 0; i < 32; ++i) scr[(2 * i + (lane >> 5)) * 33 + (lane & 31)] = v[i];
    LDS_WAIT(); asm volatile("" ::: "memory");
#pragma unroll
    for (int j = 0; j < 4; ++j) { const int n = (lane >> 3) + 8 * j; const LAS float* s = scr + (8 * c) * 33 + n;
        v4u o; o.x = pk2(s[0 * 33] * g0[0], s[1 * 33] * g0[1]); o.y = pk2(s[2 * 33] * g0[2], s[3 * 33] * g0[3]); o.z = pk2(s[4 * 33] * g1[0], s[5 * 33] * g1[1]); o.w = pk2(s[6 * 33] * g1[2], s[7 * 33] * g1[3]);
        asm volatile("global_store_dwordx4 %0, %1, off sc1\n\ts_nop 1" :: "v"(d.WT + (size_t)(d.n0 + n) * D + d.k0 + 8 * c), "v"(o) : "memory");
        if (d.cmax) { float mx = fmaxf(fmaxf(fmaxf(fabsf(s[0 * 33] * g0[0]), fabsf(s[1 * 33] * g0[1])), fmaxf(fabsf(s[2 * 33] * g0[2]), fabsf(s[3 * 33] * g0[3]))), fmaxf(fmaxf(fabsf(s[4 * 33] * g1[0]), fabsf(s[5 * 33] * g1[1])), fmaxf(fabsf(s[6 * 33] * g1[2]), fabsf(s[7 * 33] * g1[3]))));
            mx = fmaxf(mx, __shfl_xor(mx, 1)); mx = fmaxf(mx, __shfl_xor(mx, 2)); mx = fmaxf(mx, __shfl_xor(mx, 4));
            if (c == 0) atomicMax(d.cmax + d.n0 + n, __float_as_uint(mx)); } }
    LDS_WAIT(); asm volatile("" ::: "memory");
}
__device__ __forceinline__ void p0_pool_item(const float* win, const float* gpre, const float* wpool, bf16* W1T, unsigned* cmax, LAS float* scr, int item, int lane) {
    const int db = item & 3, g = (item >> 2) & 3, kb = item >> 4;
    const int k0 = 32 * kb, d0 = 32 * db, i = lane & 31, h = lane >> 5;
    float b[64];
#pragma unroll
    for (int s = 0; s < 64; ++s) b[s] = wpool[(size_t)(g * 128 + 2 * s + h) * 128 + d0 + i];
#pragma unroll
    for (int r = 0; r < 16; ++r) { const int kk = 2 * r + h; const f32x4 v = *(const f32x4*)(win + (size_t)(k0 + kk) * NIN + 2048 + 128 * g + 4 * i); const float gs = gpre[k0 + kk];
        LAS float* d = scr + kk * 129 + 4 * i; d[0] = v[0] * gs; d[1] = v[1] * gs; d[2] = v[2] * gs; d[3] = v[3] * gs; }
    LDS_WAIT(); asm volatile("" ::: "memory");
    f32x16 acc;
#pragma unroll
    for (int r = 0; r < 16; ++r) acc[r] = 0.f;
#pragma unroll
    for (int s = 0; s < 64; ++s) { const float a = scr[i * 129 + 2 * s + h]; acc = __builtin_amdgcn_mfma_f32_32x32x2f32(a, b[s], acc, 0, 0, 0); }
    const int d = d0 + i, n = 256 * (8 + g) + 32 * (d >> 5) + 16 * ((d >> 2) & 1) + 4 * ((d >> 3) & 3) + (d & 3);
#pragma unroll
    for (int q = 0; q < 4; ++q) { v2u o; o.x = pk2(acc[4 * q + 0], acc[4 * q + 1]); o.y = pk2(acc[4 * q + 2], acc[4 * q + 3]); __hip_atomic_store((unsigned long long*)(W1T + (size_t)n * D + k0 + 8 * q + 4 * h), ((unsigned long long)o.y << 32) | o.x, __ATOMIC_RELAXED, __HIP_MEMORY_SCOPE_AGENT); }
    if (cmax) { float mx = 0.f;
#pragma unroll
        for (int r = 0; r < 16; ++r) mx = fmaxf(mx, fabsf(acc[r]));
        mx = fmaxf(mx, __shfl_xor(mx, 32)); if (h == 0) atomicMax(cmax + n, __float_as_uint(mx)); }
    LDS_WAIT(); asm volatile("" ::: "memory");
}

struct Args { const float* in[9]; float* out; unsigned char* ws; int ph_lo, ph_hi; };

__device__ __forceinline__ void p0_prologue(const Args& a, LAS unsigned char* lds, int gw, int NGW, int wave, int lane) {
    LAS float* scr = (LAS float*)(lds + wave * SCR_STRIDE);
    const float* x = a.in[0]; const float* pre_norm = a.in[1]; const float* w_in = a.in[2]; const float* w_pool = a.in[5]; const float* w_out = a.in[7];
    bf16* W1T = (bf16*)(a.ws + WS_W1T); bf16* W2T = (bf16*)(a.ws + WS_W2T); bf16* XB = (bf16*)(a.ws + WS_XB); float* SSQ = (float*)(a.ws + WS_SSQ);
    constexpr int I_POOL = DEPTH * 512, I_W1 = DEPTH * 80 * 16, I_W2 = DEPTH * 32 * 16, I_TR = I_W1 + I_W2;
    unsigned* cmax = (unsigned*)(a.ws + WS_CTL) + CW_CMAX;
    { unsigned long long* xs = (unsigned long long*)(a.ws + WS_XSLOT);
      for (int i = gw * 64 + lane; i < DEPTH * M * 4; i += NGW * 64) __hip_atomic_store(xs + i, 0ull, __ATOMIC_RELAXED, __HIP_MEMORY_SCOPE_AGENT);
      unsigned long long* x2 = (unsigned long long*)(a.ws + WS_XS2);
      for (int i = gw * 64 + lane; i < M * 4; i += NGW * 64) __hip_atomic_store(x2 + i, 0ull, __ATOMIC_RELAXED, __HIP_MEMORY_SCOPE_AGENT);
      unsigned long long* hz = (unsigned long long*)(a.ws + WS_HGA);
      for (int i = gw * 64 + lane; i < DEPTH * 8 * 64 * 128; i += NGW * 64) __hip_atomic_store(hz + i, 0ull, __ATOMIC_RELAXED, __HIP_MEMORY_SCOPE_AGENT); }
#define P0_TR_DESC(d, r_) do { int r = (r_); \
        if (r < I_W1) { const int l = r / 1280, q = r % 1280, nbi = q % 80, kb = q / 80;     \
            const int n0 = nbi < 64 ? 32 * nbi : 256 * (8 + ((nbi - 64) >> 2)) + 128 + 32 * ((nbi - 64) & 3); \
            d.W = w_in + (size_t)l * D * NIN; d.gs = pre_norm + l * D; d.WT = W1T + (size_t)l * NIN * D; d.cmax = l ? cmax : nullptr; d.ldw = NIN; d.n0 = n0; d.srccol = w1_srccol(n0 + (lane & 31)); d.k0 = 64 * kb; } \
        else { r -= I_W1; const int l = r >> 9, q = r & 511, nb = q & 31, kb = q >> 5; \
            d.W = w_out + (size_t)l * D * D; d.gs = nullptr; d.WT = W2T + (size_t)l * D * D; d.cmax = nullptr; d.ldw = D; d.n0 = 32 * nb; d.srccol = 32 * nb + (lane & 31); d.k0 = 64 * kb; } } while (0)
    if (NGW == 2048) {
        if (gw < I_POOL) {
            TrItem d; float v[32]; const bool has = gw < I_TR - 3 * 1024;
            if (has) { P0_TR_DESC(d, 3 * 1024 + gw); tr_load(d, lane, v); }
            { const int l = gw >> 9; p0_pool_item(w_in + (size_t)l * D * NIN, pre_norm + l * D, w_pool + (size_t)l * 4 * 128 * 128, W1T + (size_t)l * NIN * D, l ? cmax : nullptr, scr, gw & 511, lane); }
            if (has) tr_finish(d, v, scr, lane);
        } else {
            TrItem d0, d1, d2; float v0[32], v1[32], v2[32]; const int t0 = (gw - 1024) * 3;
            P0_TR_DESC(d0, t0); tr_load(d0, lane, v0); P0_TR_DESC(d1, t0 + 1); tr_load(d1, lane, v1); P0_TR_DESC(d2, t0 + 2); tr_load(d2, lane, v2);
            tr_finish(d0, v0, scr, lane); tr_finish(d1, v1, scr, lane); tr_finish(d2, v2, scr, lane);
        }
    } else {
        for (int it = gw; it < I_POOL + I_TR; it += NGW) {
            if (it < I_POOL) { const int l = it >> 9; p0_pool_item(w_in + (size_t)l * D * NIN, pre_norm + l * D, w_pool + (size_t)l * 4 * 128 * 128, W1T + (size_t)l * NIN * D, l ? cmax : nullptr, scr, it & 511, lane); }
            else { TrItem d; float v[32]; P0_TR_DESC(d, it - I_POOL); tr_load(d, lane, v); tr_finish(d, v, scr, lane); }
        }
    }
#undef P0_TR_DESC
    const int xstep = (NGW == 2048) ? 1 : NGW, xc = gw >> 3;
    const int xfirst = (NGW == 2048) ? (8 * (xc & 7) + ((xc >> 3) & 7)) * 256 + (xc >> 6) * 64 + (gw & 7) * 8 : gw, xend = (NGW == 2048) ? xfirst + 8 : M;
    for (int r0 = xfirst; r0 < xend; r0 += 4 * xstep) {
        f32x4 v[4][4];
#pragma unroll
        for (int q = 0; q < 4; ++q) { const f32x4* xr = (const f32x4*)(x + (size_t)(r0 + q * xstep) * D) + lane;
#pragma unroll
            for (int j = 0; j < 4; ++j) v[q][j] = (r0 + q * xstep < M) ? __builtin_nontemporal_load(xr + 64 * j) : (f32x4){0.f, 0.f, 0.f, 0.f}; }
#pragma unroll
        for (int q = 0; q < 4; ++q) { const int r = r0 + q * xstep; if (r >= M) break; float s = 0.f;
#pragma unroll
            for (int j = 0; j < 4; ++j) s += (v[q][j][0] * v[q][j][0] + v[q][j][1] * v[q][j][1]) + (v[q][j][2] * v[q][j][2] + v[q][j][3] * v[q][j][3]);
            s = wave_sum(s);
            if (lane == 0) *(f32x4*)(SSQ + (size_t)r * 4) = (f32x4){s, 0.f, 0.f, 0.f};
            v2u* o8 = (v2u*)(XB + (size_t)r * D) + lane;
#pragma unroll
            for (int j = 0; j < 4; ++j) { v2u o; o.x = pk2(v[q][j][0], v[q][j][1]); o.y = pk2(v[q][j][2], v[q][j][3]); o8[64 * j] = o; } }
    }
}

__device__ __forceinline__ void p0_quantize_w1(const Args& a, int gw, int NGW, int lane) {
    const bf16* W1T1 = (const bf16*)(a.ws + WS_W1T) + (size_t)NIN * D; signed char* W1Q = (signed char*)(a.ws + WS_W1Q); float* SW = (float*)(a.ws + WS_SW);
    unsigned* ctl = (unsigned*)(a.ws + WS_CTL);
    for (int n = gw; n < NIN; n += NGW) {
        const float cm = fmaxf(__uint_as_float(__hip_atomic_load(ctl + CW_CMAX + n, __ATOMIC_RELAXED, __HIP_MEMORY_SCOPE_AGENT)), 1e-30f), qs = 127.0f / cm;
        const v4u p0 = *(const v4u*)(W1T1 + (size_t)n * D + 16 * lane), p1 = *(const v4u*)(W1T1 + (size_t)n * D + 16 * lane + 8);
        const unsigned w[8] = {p0.x, p0.y, p0.z, p0.w, p1.x, p1.y, p1.z, p1.w}; unsigned o[4];
#pragma unroll
        for (int i = 0; i < 4; ++i) { unsigned r = 0u;
#pragma unroll
            for (int j = 0; j < 2; ++j) { const unsigned ww = w[2 * i + j]; const float lo = __uint_as_float(ww << 16) * qs, hi = __uint_as_float(ww & 0xffff0000u) * qs;
                const int ql = max(-127, min(127, (int)rintf(lo))), qh = max(-127, min(127, (int)rintf(hi)));
                r |= ((unsigned)(ql & 0xff) | ((unsigned)(qh & 0xff) << 8)) << (16 * j); }
            o[i] = r; }
        const v4u ov = {o[0], o[1], o[2], o[3]};
        asm volatile("global_store_dwordx4 %0, %1, off sc1\n\ts_nop 1" :: "v"(W1Q + (size_t)n * D + 16 * lane), "v"(ov) : "memory");
        if (lane == 0) __hip_atomic_store(SW + n, cm * (1.0f / 127.0f), __ATOMIC_RELAXED, __HIP_MEMORY_SCOPE_AGENT);
    }
    asm volatile("s_waitcnt vmcnt(0)" ::: "memory");
    __syncthreads();
    if (threadIdx.x == 0) (void)__hip_atomic_fetch_add(ctl + CW_QCNT, 1u, __ATOMIC_RELAXED, __HIP_MEMORY_SCOPE_AGENT);
}

__global__ void __launch_bounds__(NWAVES * 64, 2) mk_fwd(Args args) {
    extern __shared__ __attribute__((aligned(16))) unsigned char lds_raw[];
    LAS unsigned char* lds = (LAS unsigned char*)lds_raw;
    volatile LAS unsigned* MISC = (volatile LAS unsigned*)(lds + MISC_OFF);
    const int tid = threadIdx.x, lane = tid & 63, wave = __builtin_amdgcn_readfirstlane(tid >> 6);
    const int G = gridDim.x;
    unsigned char* ws = args.ws;
    unsigned* ctl = (unsigned*)(ws + WS_CTL);
    if (tid < 64) MISC[tid] = 0u;
    __syncthreads();
    if (tid == 0) __hip_atomic_store(ctl + CW_XCC + blockIdx.x, xb_xcc_id() + 1u, __ATOMIC_RELAXED, __HIP_MEMORY_SCOPE_AGENT);
    XcdBarrier bar; bar.bar = ctl + CW_BAR; bar.x = 0; bar.st = nullptr;
    if (N_LAUNCHES == 1) bar = xcd_barrier_post(ctl + CW_BAR, MISC + 8);
#define GRID_BAR() do { if (N_LAUNCHES == 1) xcd_barrier(bar); } while (0)
    const int lo = args.ph_lo, hi = args.ph_hi;
#define IN(k) (lo <= (k) && (k) < hi)
    bf16* W1T = (bf16*)(ws + WS_W1T); bf16* W2T = (bf16*)(ws + WS_W2T); bf16* XB = (bf16*)(ws + WS_XB); bf16* Y = (bf16*)(ws + WS_Y);
    float* SSQ = (float*)(ws + WS_SSQ);

#define PHASE_P0() do { if (IN(0)) { PROF_START(25, lds, wave); p0_prologue(args, lds, blockIdx.x * NWAVES + wave, G * NWAVES, wave, lane); PROF_STOP(25, lds, wave); PROF_START(24, lds, wave); P0_PARTNERS(); if (N_LAUNCHES == 1) { if (quad) xcd_barrier(bar, false, MISC[17] != 0u); else xcd_barrier(bar); } PROF_STOP(24, lds, wave); p0_quantize_w1(args, blockIdx.x * NWAVES + wave, G * NWAVES, lane); } } while (0)
    int my_pm; { pg8::StaticOrder S; S.init(M, NIN, G, (int)blockIdx.x); pg8::Unit u0, u1; S.next(0, u0); my_pm = u0.pm; bool same = true; for (int i = 1; S.next(i, u1); ++i) same &= (u1.pm == u0.pm);
                 pg8::StaticOrder S2; S2.init(M, D, G, (int)blockIdx.x); S2.next(0, u1); same &= (u1.pm == u0.pm) && G == 256; if (!same) my_pm = -1; }
    const bool quad = (MK_QUAD != 0) && N_LAUNCHES == 1 && my_pm >= 0;
    unsigned* seamw = ctl + CW_CNT + (my_pm < 0 ? 0 : my_pm) * 16;
#define SEAM_DONE(s_) do { PROF_START(21, lds, wave); if (quad) seam_arrive(seamw + (s_) * 1024, MISC[17] != 0u); else GRID_BAR(); PROF_STOP(21, lds, wave); } while (0)
#define SEAM_WAIT(s_) do { PROF_START(20, lds, wave); if (quad) seam_wait(seamw + (s_) * 1024, 4u, ctl + CW_TMO, 0x600u + (s_)); PROF_STOP(20, lds, wave); } while (0)
#define PHASE_G1(l) do { if (IN(1 + 2 * (l))) { \
            if ((l) > 0) SEAM_WAIT(1); \
            if ((l) > 0) { if (tid < 64) { unsigned sp = 0; while ((unsigned)__builtin_amdgcn_readfirstlane(__hip_atomic_load(ctl + CW_QCNT, __ATOMIC_RELAXED, __HIP_MEMORY_SCOPE_AGENT)) < (unsigned)G && ++sp < (1u << 20)) __builtin_amdgcn_s_sleep(1); } __syncthreads(); }     \
            pg8::Gemm g{(l) ? (const bf16*)(ws + WS_XQ) : XB, (l) ? (const bf16*)(ws + WS_W1Q) : W1T, M, NIN, (l) ? D / 2 : D};     \
            pg8::StaticOrder S; S.init(M, NIN, G, (int)blockIdx.x); \
            pg8::EpiMixT<(l) == 1> E{Y, SSQ, args.in[3] + (size_t)(l) * 3 * 512, args.in[4] + (size_t)(l) * 512, args.in[6] + (size_t)(l) * 512, \
                          (float*)(ws + WS_HALO) + (size_t)(l) * 768 * pg8::HALO_TILE, ctl + CW_FLAG + (l) * 768 * 16, ctl + CW_TMO, (unsigned)((l) + 1), (const float*)(ws + WS_SA), (const float*)(ws + WS_SW), (unsigned long long*)(ws + WS_HGA) + (size_t)(l) * 8 * 64 * 128}; \
            pg8::gemm_phase<pg8::EpiMixT<(l) == 1>, pg8::StaticOrder, true, true, (l) == 1>(lds, g, S, E); \
            SEAM_DONE(2 * (l)); } } while (0)
#define PHASE_G2_0() do { if (IN(2)) { \
        SEAM_WAIT(0); \
        pg8::Gemm g{Y, W2T, M, D, D}; pg8::StaticOrder S; S.init(M, D, G, (int)blockIdx.x); \
        pg8::EpiRms<0> E{XB, nullptr, XB, SSQ, args.in[8], (unsigned long long*)(ws + WS_XSLOT), ctl + CW_TMO, 1u, (unsigned long long*)(ws + WS_XS2), (float*)(ws + WS_SA), (signed char*)(ws + WS_XQ)}; \
        pg8::gemm_phase<pg8::EpiRms<0>, pg8::StaticOrder, false, true>(lds, g, S, E); SEAM_DONE(1); } } while (0)
#define PHASE_G2_1(last) do { if (IN(4)) { \
        SEAM_WAIT(2); \
        pg8::Gemm g{Y, W2T + (size_t)D * D, M, D, D}; pg8::StaticOrder S; S.init(M, D, G, (int)blockIdx.x); \
        pg8::EpiRms<1> E{XB, args.out, nullptr, nullptr, args.in[8] + D, (unsigned long long*)(ws + WS_XSLOT) + (size_t)M * 4, ctl + CW_TMO, 2u, nullptr, nullptr, nullptr}; \
        pg8::gemm_phase<pg8::EpiRms<1>, pg8::StaticOrder, false, true>(lds, g, S, E); if (!(last)) GRID_BAR(); } } while (0)
#define P0_PARTNERS() do { if (quad && tid == 0) { \
        const unsigned c0 = (blockIdx.x & 7u) + 8u * ((blockIdx.x >> 3) & 7u); const unsigned mine = xb_xcc_id() + 1u; unsigned diff = 0u; \
        for (unsigned k = 0; k < 4; ++k) { unsigned v = 0u, sp = 0u; \
            while ((v = __hip_atomic_load(ctl + CW_XCC + c0 + 64u * k, __ATOMIC_RELAXED, __HIP_MEMORY_SCOPE_AGENT)) == 0u && ++sp < (1u << 16)) __builtin_amdgcn_s_sleep(1); \
            diff |= (v != mine) ? 1u : 0u; } \
        MISC[17] = diff; } \
    __syncthreads(); } while (0)
    PHASE_P0();
    PHASE_G1(0);
    PHASE_G2_0();
    PHASE_G1(1);
    PHASE_G2_1(true);
#undef PHASE_P0
#undef P0_PARTNERS
#undef SEAM_DONE
#undef SEAM_WAIT
#undef PHASE_G2_0
#undef PHASE_G2_1
    if (PROF_ID != 0 && blockIdx.x == PROF_BLOCK && tid == 0) {
        const unsigned long long t0 = __builtin_amdgcn_s_memrealtime();
#ifdef PROF_CLK
        const unsigned long long want = (unsigned long long)MISC[20] / 10u;
#else
        const unsigned long long want = (unsigned long long)MISC[20] * PROF_SCALE;
#endif

        while (__builtin_amdgcn_s_memrealtime() - t0 < want) __builtin_amdgcn_s_sleep(8);
    }
#undef PHASE_G1
#undef IN
#undef GRID_BAR
}

extern "C" void kernel_launch(void* const* d_in, const int* in_sizes, int n_in, void* d_out, int out_size, void* d_ws, size_t ws_size, hipStream_t stream) {
    static int grid = 0;
    if (grid == 0) {
        if (n_in != 9 || in_sizes[0] != M * D || out_size != M * D || ws_size < WS_END) { fprintf(stderr, "kernel_launch: unexpected shapes (n_in %d, in0 %d, out %d, ws %zu); nothing launched\n", n_in, n_in > 0 ? in_sizes[0] : -1, out_size, ws_size); grid = -1; return; }
        int dev = 0, cus = 0, per_cu = 0;
        if (hipGetDevice(&dev) != hipSuccess || hipDeviceGetAttribute(&cus, hipDeviceAttributeMultiprocessorCount, dev) != hipSuccess) { grid = -1; return; }
        if (hipFuncSetAttribute((const void*)mk_fwd, hipFuncAttributeMaxDynamicSharedMemorySize, LDS_BYTES) != hipSuccess) { fprintf(stderr, "kernel_launch: hipFuncSetAttribute failed\n"); grid = -1; return; }
        if (hipOccupancyMaxActiveBlocksPerMultiprocessor(&per_cu, (const void*)mk_fwd, NWAVES * 64, LDS_BYTES) != hipSuccess || per_cu < 1) fprintf(stderr, "kernel_launch: occupancy query reports %d blocks per CU\n", per_cu);
        (void)hipGetLastError();
        grid = cus;
        if (grid != 256) fprintf(stderr, "kernel_launch: %d CUs; the fused GEMM2 epilogue expects 256 workgroups\n", grid);
    }
    if (grid < 0) return;
    (void)hipMemsetAsync((char*)d_ws + WS_CTL, 0, CTL_ZERO_BYTES, stream);
    Args a{};
    for (int i = 0; i < 9; ++i) a.in[i] = (const float*)d_in[i];
    a.out = (float*)d_out; a.ws = (unsigned char*)d_ws;
    for (int li = 0; li < N_LAUNCHES; ++li) {
        a.ph_lo = (N_LAUNCHES == 1) ? 0 : li; a.ph_hi = (N_LAUNCHES == 1) ? N_PHASES : li + 1;
        hipLaunchKernelGGL(mk_fwd, dim3(grid), dim3(NWAVES * 64), LDS_BYTES, stream, a);
    }
}
```

```cpp
#include <hip/hip_runtime.h>
#include <cstdio>
#include <cstdint>
#ifndef MK_QUAD
#define MK_QUAD 1
#endif
namespace pg8 {
#define PG8_LAS __attribute__((address_space(3)))
typedef unsigned short bf16_t;
typedef short bf16x8 __attribute__((ext_vector_type(8)));
typedef float f32x4 __attribute__((ext_vector_type(4)));
typedef unsigned u32x4 __attribute__((ext_vector_type(4)));
constexpr int BM = 256, BK = 64, HALF = 128, HTB = HALF * BK * 2  , STAGE_BYTES = 8 * HTB, NXCD = 8, WGM = 8;

__host__ __device__ __forceinline__ int lds_byte(int r, int c) { const int st = (r >> 4) * 2 + (c >> 5), rr = r & 15, cc = c & 31, ob = rr * 64 + cc * 2; return st * 1024 + (ob ^ (((ob >> 9) & 1) << 5)); }
__host__ __device__ __forceinline__ void stage_rc(int b, int& R, int& C) { const int st = b / 1024, sb = b % 1024, swz = sb ^ (((sb >> 9) & 1) << 5); R = (st >> 1) * 16 + swz / 64; C = (st & 1) * 32 + (swz % 64) / 2; }
__host__ __device__ __forceinline__ int perm32(int rho) { const int n = rho >> 4, i = rho & 15; return 8 * (i >> 2) + 4 * n + (i & 3); }

struct Unit { int pm, pn; };
struct Gemm { const bf16_t* A; const bf16_t* Bt; int M, N, K; };

struct StaticOrder {
    int nM, nN, nwg, G, c;
    __host__ __device__ __forceinline__ void init(int M, int N, int G_, int c_) { nM = M / BM; nN = N / BM; nwg = nM * nN; G = G_; c = c_; }
    __host__ __device__ __forceinline__ bool next(int i, Unit& u) const {
        const long L = (long)i * G + c; if (L >= nwg) return false;
        int wgid = (int)L; { const int q = nwg / NXCD, r = nwg % NXCD, xcd = wgid % NXCD, off = wgid / NXCD; wgid = (xcd < r ? xcd * (q + 1) : r * (q + 1) + (xcd - r) * q) + off; }
        const int nig = WGM * nN, gid = wgid / nig, fm = gid * WGM, gsz = (nM - fm) < WGM ? (nM - fm) : WGM;
        u.pm = fm + ((wgid % nig) % gsz); u.pn = (wgid % nig) / gsz; return true;
    }
    __device__ __forceinline__ void a_ready(const Unit&) const {}
    __device__ __forceinline__ void done(const Unit&) const {}
};


typedef unsigned u32x2 __attribute__((ext_vector_type(2)));
typedef int i32x4 __attribute__((ext_vector_type(4)));
__device__ __forceinline__ unsigned cvt_pk_bf16(float lo, float hi) { unsigned r; asm volatile("v_cvt_pk_bf16_f32 %0, %1, %2" : "=v"(r) : "v"(lo), "v"(hi)); return r; }
__device__ __forceinline__ float silu_f(float z) { return z * __builtin_amdgcn_rcpf(1.0f + __expf(-z)); }
__device__ __forceinline__ f32x4 mul_silu4(const f32x4& x, const f32x4& z) {
    const f32x4 t = z * (-1.44269504089f);
    f32x4 e; e[0] = __builtin_amdgcn_exp2f(t[0]); e[1] = __builtin_amdgcn_exp2f(t[1]); e[2] = __builtin_amdgcn_exp2f(t[2]); e[3] = __builtin_amdgcn_exp2f(t[3]);
    const f32x4 d = e + 1.0f;
    f32x4 r; r[0] = __builtin_amdgcn_rcpf(d[0]); r[1] = __builtin_amdgcn_rcpf(d[1]); r[2] = __builtin_amdgcn_rcpf(d[2]); r[3] = __builtin_amdgcn_rcpf(d[3]);
    return (x * z) * r;
}
template <int K> __device__ __forceinline__ float shl_prev(float cur, float prev) {
    const int t = __builtin_amdgcn_update_dpp(0, __float_as_int(prev), 0x120 + K, 0xf, 0xf, false);
    return __int_as_float(__builtin_amdgcn_update_dpp(t, __float_as_int(cur), 0x110 + K, 0xf, 0xf, false));
}
template <int K> __device__ __forceinline__ float shl_zero(float cur) { return __int_as_float(__builtin_amdgcn_update_dpp(0, __float_as_int(cur), 0x110 + K, 0xf, 0xf, true)); }

constexpr int HBS = 132;
constexpr int HB_BYTES = 3 * 16 * HBS * 4;
constexpr int HALO_TILE = 16 * 128;
constexpr int EPI_HB_OFF = STAGE_BYTES, EPI_MISC_OFF = EPI_HB_OFF + 25600, EPI_INV_OFF = EPI_MISC_OFF + 256, EPI_LDS_END = EPI_INV_OFF + 1024;
static_assert(HB_BYTES <= 25600, "halo images");

#ifndef PROF_ID
#define PROF_ID 0
#endif
#ifndef PROF_BLOCK
#define PROF_BLOCK 9
#endif
#ifndef PROF_WAVE
#define PROF_WAVE 0
#endif
#define PROF_SCALE 20u
#ifdef PROF_CLK
#define PROF_NOW() ((unsigned)__builtin_amdgcn_s_memtime())
#else
#define PROF_NOW() ((unsigned)__builtin_amdgcn_s_memrealtime())
#endif
#define PROF_START(n, lds_, wid_) do { if (PROF_ID == (n) && blockIdx.x == PROF_BLOCK && (wid_) == PROF_WAVE) { const unsigned t_ = PROF_NOW(); \
        if ((threadIdx.x & 63) == 0) ((volatile PG8_LAS unsigned*)((lds_) + pg8::EPI_MISC_OFF))[22] = t_; } } while (0)
#define PROF_STOP(n, lds_, wid_) do { if (PROF_ID == (n) && blockIdx.x == PROF_BLOCK && (wid_) == PROF_WAVE) { const unsigned t_ = PROF_NOW(); \
        if ((threadIdx.x & 63) == 0) { volatile PG8_LAS unsigned* m_ = (volatile PG8_LAS unsigned*)((lds_) + pg8::EPI_MISC_OFF); m_[20] = m_[20] + (t_ - m_[22]); } } } while (0)

__device__ __forceinline__ u32x2 mixA_block(const f32x4& gate, const f32x4& chv, const f32x4& prev, const f32x4& w0, const f32x4& w1, const f32x4& w2, const f32x4& cb) {
    f32x4 c1, c2;
#pragma unroll
    for (int j = 0; j < 4; ++j) { c1[j] = shl_prev<1>(chv[j], prev[j]); c2[j] = shl_prev<2>(chv[j], prev[j]); }
    const f32x4 o = gate * (w0 * c2 + w1 * c1 + w2 * chv + cb);
    u32x2 w; w.x = cvt_pk_bf16(o[0], o[1]); w.y = cvt_pk_bf16(o[2], o[3]); return w;
}
__device__ __forceinline__ u32x4 mixB_block(const f32x4 (&cu)[2], const f32x4 (&pu)[2], const f32x4 (&sg)[2], float rc, int w) {
    float o[8];
#pragma unroll
    for (int e = 0; e < 8; ++e) {
        const float uv = cu[e >> 2][e & 3], up = pu[e >> 2][e & 3];
        float s = uv + shl_prev<1>(uv, up);
        if (w >= 4) { float sp = up + shl_zero<1>(up); s += shl_prev<2>(s, sp);
            if (w >= 8) { sp += shl_zero<2>(sp); s += shl_prev<4>(s, sp);
                if (w >= 16) { sp += shl_zero<4>(sp); s += shl_prev<8>(s, sp); } } }
        o[e] = (s * rc - uv) * sg[e >> 2][e & 3];
    }
    u32x4 wv; wv.x = cvt_pk_bf16(o[0], o[1]); wv.y = cvt_pk_bf16(o[2], o[3]); wv.z = cvt_pk_bf16(o[4], o[5]); wv.w = cvt_pk_bf16(o[6], o[7]); return wv;
}
template <int K> __device__ __forceinline__ float shl_zero_fwd(float cur) { return __int_as_float(__builtin_amdgcn_update_dpp(0, __float_as_int(cur), 0x100 + K, 0xf, 0xf, true)); }
template <int K> __device__ __forceinline__ float row_ror(float cur) { return __int_as_float(__builtin_amdgcn_update_dpp(0, __float_as_int(cur), 0x120 + K, 0xf, 0xf, false)); }
template <int W> __device__ __forceinline__ void lead_sums(const f32x4 (&p)[2], f32x4 (&q)[2]) {
#pragma unroll
    for (int e = 0; e < 8; ++e) { float t = p[e >> 2][e & 3]; t += shl_zero_fwd<1>(t); if (W >= 4) t += shl_zero_fwd<2>(t); if (W >= 8) t += shl_zero_fwd<4>(t); if (W >= 16) t += shl_zero_fwd<8>(t); q[e >> 2][e & 3] = t; }
}
template <int W> __device__ __forceinline__ u32x4 mixB_blockT(const f32x4 (&cu)[2], const f32x4 (&pq)[2], const f32x4 (&sg)[2], float rc, float maskf) {
    float o[8];
#pragma unroll
    for (int e = 0; e < 8; ++e) {
        const float uv = cu[e >> 2][e & 3];
        float s = uv + shl_zero<1>(uv); if (W >= 4) s += shl_zero<2>(s); if (W >= 8) s += shl_zero<4>(s); if (W >= 16) s += shl_zero<8>(s);
        s = fmaf(row_ror<W - 1>(pq[e >> 2][e & 3]), maskf, s);
        o[e] = (s * rc - uv) * sg[e >> 2][e & 3];
    }
    u32x4 wv; wv.x = cvt_pk_bf16(o[0], o[1]); wv.y = cvt_pk_bf16(o[2], o[3]); wv.z = cvt_pk_bf16(o[4], o[5]); wv.w = cvt_pk_bf16(o[6], o[7]); return wv;
}
__device__ __forceinline__ void st_sc1_f32x4(float* p, const f32x4& v) {
    __hip_atomic_store((unsigned long long*)p, ((unsigned long long)__float_as_uint(v[1]) << 32) | __float_as_uint(v[0]), __ATOMIC_RELAXED, __HIP_MEMORY_SCOPE_AGENT);
    __hip_atomic_store((unsigned long long*)p + 1, ((unsigned long long)__float_as_uint(v[3]) << 32) | __float_as_uint(v[2]), __ATOMIC_RELAXED, __HIP_MEMORY_SCOPE_AGENT);
}
__device__ __forceinline__ void st_pay_u32x2(void* p, const u32x2& v) {
    *(u32x2*)p = v;
}
__device__ __forceinline__ void st_pay_u32x4(void* p, const u32x4& v) {
    *(u32x4*)p = v;
}
__device__ __forceinline__ void st_pay_f32(float* p, float v) {
    *p = v;
}
__device__ __forceinline__ f32x4 ld_sc1_f32x4(const float* p) {
    const unsigned long long a = __hip_atomic_load((unsigned long long*)p, __ATOMIC_RELAXED, __HIP_MEMORY_SCOPE_AGENT), b = __hip_atomic_load((unsigned long long*)p + 1, __ATOMIC_RELAXED, __HIP_MEMORY_SCOPE_AGENT);
    return (f32x4){__uint_as_float((unsigned)a), __uint_as_float((unsigned)(a >> 32)), __uint_as_float((unsigned)b), __uint_as_float((unsigned)(b >> 32))};
}

template <bool I8> struct EpiMixT {
    static constexpr bool PERM = false, AFTER_DRAIN = false;
    bf16_t* Y; const float* ssqp; const float* convw; const float* convb; const float* pscale;
    float* halo; unsigned* flags; unsigned* tmo; unsigned epoch;
    const float* sa; const float* sw;
    unsigned long long* hga;
    __device__ __forceinline__ void sweepA(const unsigned long long* g, bool active, f32x4& v, const Unit& u, int lane) const {
        for (unsigned sp = 0;;) { bool ok = true;
            if (active) {
#pragma unroll
                for (int k = 0; k < 4; ++k) { const unsigned long long x = __hip_atomic_load((unsigned long long*)g + k, __ATOMIC_RELAXED, __HIP_MEMORY_SCOPE_AGENT); v[k] = __uint_as_float((unsigned)x); ok &= ((unsigned)(x >> 32) == epoch); } }
            if (__all(ok)) return;
            __builtin_amdgcn_s_sleep(2);
            if (++sp > (1u << 20)) { if (lane == 0) __hip_atomic_store(tmo, 0x500u | (unsigned)u.pn, __ATOMIC_RELAXED, __HIP_MEMORY_SCOPE_AGENT); return; } }
    }
    __device__ __forceinline__ void wait_flag(const Unit& u, int lane) const {
        unsigned sp = 0; unsigned* fl = flags + ((u.pm - 1) * 12 + u.pn) * 16; const unsigned want = 4u;
        while ((unsigned)__builtin_amdgcn_readfirstlane(__hip_atomic_load(fl, __ATOMIC_RELAXED, __HIP_MEMORY_SCOPE_AGENT)) < want) { __builtin_amdgcn_s_sleep(1);
            if (++sp > (1u << 20)) { if (lane == 0) __hip_atomic_store(tmo, 0x500u | (unsigned)u.pn, __ATOMIC_RELAXED, __HIP_MEMORY_SCOPE_AGENT); break; } }
    }
    __device__ __forceinline__ u32x4 b_block(int g, const f32x4 (&cu)[2], const f32x4 (&pu)[2], const f32x4 (&sg)[2], float rc, int fr) const {
        f32x4 q[2]; u32x4 r;
        if (g == 0) { lead_sums<2>(pu, q); r = mixB_blockT<2>(cu, q, sg, rc, fr < 1 ? 1.0f : 0.0f); }
        else if (g == 1) { lead_sums<4>(pu, q); r = mixB_blockT<4>(cu, q, sg, rc, fr < 3 ? 1.0f : 0.0f); }
        else if (g == 2) { lead_sums<8>(pu, q); r = mixB_blockT<8>(cu, q, sg, rc, fr < 7 ? 1.0f : 0.0f); }
        else { lead_sums<16>(pu, q); r = mixB_blockT<16>(cu, q, sg, rc, fr < 15 ? 1.0f : 0.0f); }
        return r;
    }
    __device__ __forceinline__ void operator()(f32x4 (&acc)[2][2][4][2], const Unit& u, int wr, int wc, int fr, int fq, PG8_LAS unsigned char* lds, int wid, int lane) const {
        asm volatile("" : "+v"(fr), "+v"(fq), "+v"(lane));
        f32x4 swv[2][2];
        if constexpr (I8) { const float* swp = sw + u.pn * BM + 32 * wc + 4 * fq;
#pragma unroll
            for (int bj = 0; bj < 2; ++bj)
#pragma unroll
                for (int n = 0; n < 2; ++n) swv[bj][n] = *(const f32x4*)(swp + HALF * bj + 16 * n); }
        PROF_START(2, lds, wid);
        PG8_LAS float* HB = (PG8_LAS float*)(lds + EPI_HB_OFF);
        PG8_LAS float* INV = (PG8_LAS float*)(lds + EPI_INV_OFF);
        volatile PG8_LAS unsigned* KEY = (volatile PG8_LAS unsigned*)(lds + EPI_MISC_OFF + 64);
        const unsigned key = (epoch << 16) | (unsigned)u.pm;
        if (KEY[0] != key) {
            int t = threadIdx.x; asm volatile("" : "+v"(t));
            if (t < 256) { const f32x4 p = *(const f32x4*)(ssqp + (size_t)(u.pm * BM + t) * 4); INV[t] = rsqrtf(((p[0] + p[1]) + (p[2] + p[3])) * (1.0f / 1024.0f) + 1e-6f) * (I8 ? sa[(size_t)u.pm * BM + t] : 1.0f); }
            asm volatile("s_waitcnt lgkmcnt(0)" ::: "memory"); __builtin_amdgcn_s_barrier(); asm volatile("" ::: "memory");
            if (t == 0) KEY[0] = key;
        }
        const int rl = wr * 64 + fr, row0 = u.pm * BM + rl;
        const bool need = (u.pm & 31) != 0;
        float* halo_out = halo + (size_t)(u.pn * 64 + u.pm) * HALO_TILE;
        const float* halo_in = halo_out - HALO_TILE;
        unsigned* myflag = flags + (u.pm * 12 + u.pn) * 16;
        float inv[2][4];
#pragma unroll
        for (int ai = 0; ai < 2; ++ai)
#pragma unroll
            for (int m = 0; m < 4; ++m) inv[ai][m] = INV[rl + ai * HALF + m * 16];
        const f32x4 zero = {0.f, 0.f, 0.f, 0.f};
        if constexpr (I8) {
#pragma unroll
            for (int bj = 0; bj < 2; ++bj)
#pragma unroll
                for (int n = 0; n < 2; ++n)
#pragma unroll
                    for (int ai = 0; ai < 2; ++ai)
#pragma unroll
                        for (int m = 0; m < 4; ++m) acc[ai][bj][m][n] = __builtin_convertvector(__builtin_bit_cast(i32x4, acc[ai][bj][m][n]), f32x4) * swv[bj][n];
        }
        if (u.pn < 8) {
            const int chl = 16 * wc + 4 * fq, chg = 64 * u.pn + chl;
            const f32x4 w0 = *(const f32x4*)(convw + chg), w1 = *(const f32x4*)(convw + 512 + chg), w2 = *(const f32x4*)(convw + 1024 + chg), cb = *(const f32x4*)(convb + chg);
            unsigned long long* ga = hga + (size_t)(u.pn * 64 + u.pm) * 128 + (fr >= 14 ? (fr - 14) * 64 + chl : 0);
            if (wr == 1 && fr >= 14) { const float s = inv[1][3]; const f32x4 t = (acc[1][0][3][1] * s) * (acc[1][1][3][0] * s);
#pragma unroll
                for (int j = 0; j < 4; ++j) __hip_atomic_store(ga + j, ((unsigned long long)epoch << 32) | __float_as_uint(t[j]), __ATOMIC_RELAXED, __HIP_MEMORY_SCOPE_AGENT); }
#pragma unroll
            for (int ai = 0; ai < 2; ++ai)
#pragma unroll
                for (int m = 0; m < 4; ++m) { const float s = inv[ai][m]; const f32x4 b = acc[ai][0][m][0] * s, c = acc[ai][0][m][1] * s, h = acc[ai][1][m][0] * s, z = acc[ai][1][m][1] * s; f32x4 g;
#pragma unroll
                    for (int j = 0; j < 4; ++j) g[j] = 0.f;
                    acc[ai][0][m][0] = mul_silu4(b, z); acc[ai][0][m][1] = c * h; }
            PROF_STOP(2, lds, wid); PROF_START(3, lds, wid);
            if (fr >= 14) {
                *(PG8_LAS f32x4*)(HB + (wr * 16 + fr) * HBS + chl) = acc[0][0][3][1];
                if (wr == 0) *(PG8_LAS f32x4*)(HB + (32 + fr) * HBS + chl) = acc[1][0][3][1];
            }
            asm volatile("s_waitcnt lgkmcnt(0)" ::: "memory"); __builtin_amdgcn_s_barrier(); asm volatile("" ::: "memory");
            PROF_STOP(3, lds, wid); PROF_START(4, lds, wid);
            u32x2 o[2][4];
            { const f32x4 pv = (fr >= 14) ? *(const PG8_LAS f32x4*)(HB + ((1 + wr) * 16 + fr) * HBS + chl) : zero;
              o[1][0] = mixA_block(acc[1][0][0][0], acc[1][0][0][1], pv, w0, w1, w2, cb); }
#pragma unroll
            for (int m = 1; m < 4; ++m) o[1][m] = mixA_block(acc[1][0][m][0], acc[1][0][m][1], acc[1][0][m - 1][1], w0, w1, w2, cb);
            PROF_STOP(4, lds, wid); PROF_START(5, lds, wid);
            f32x4 pvg = zero;
            if (wr == 1) { if (fr >= 14) pvg = *(const PG8_LAS f32x4*)(HB + fr * HBS + chl); }
            else if (need) sweepA(ga - 128, fr >= 14, pvg, u, lane);
            PROF_STOP(5, lds, wid); PROF_START(6, lds, wid);
#pragma unroll
            for (int m = 1; m < 4; ++m) o[0][m] = mixA_block(acc[0][0][m][0], acc[0][0][m][1], acc[0][0][m - 1][1], w0, w1, w2, cb);
            o[0][0] = mixA_block(acc[0][0][0][0], acc[0][0][0][1], pvg, w0, w1, w2, cb);
            PROF_STOP(6, lds, wid); PROF_START(7, lds, wid);
            bf16_t* yp = Y + (size_t)row0 * 1024 + chg;
#pragma unroll
            for (int ai = 0; ai < 2; ++ai)
#pragma unroll
                for (int m = 0; m < 4; ++m) st_pay_u32x2(yp + (size_t)(ai * HALF + 16 * m) * 1024, o[ai][m]);
            PROF_STOP(7, lds, wid);
        } else {
            const int g = u.pn - 8, dl = 32 * wc + 8 * fq;
            const f32x4 sc0 = *(const f32x4*)(pscale + 128 * g + dl), sc1 = *(const f32x4*)(pscale + 128 * g + dl + 4);
            if (wr == 1) { const float s = inv[1][3]; st_sc1_f32x4(halo_out + fr * 128 + dl, acc[1][0][3][0] * s); st_sc1_f32x4(halo_out + fr * 128 + dl + 4, acc[1][0][3][1] * s); }
#pragma unroll
            for (int ai = 0; ai < 2; ++ai)
#pragma unroll
                for (int m = 0; m < 4; ++m) { const float s = inv[ai][m];
#pragma unroll
                    for (int n = 0; n < 2; ++n) { const f32x4 uu = acc[ai][0][m][n] * s, z = acc[ai][1][m][n] * s; f32x4 sg;
#pragma unroll
                        for (int j = 0; j < 4; ++j) sg[j] = 0.f;
                        acc[ai][0][m][n] = uu; acc[ai][1][m][n] = mul_silu4(n ? sc1 : sc0, z); } }
            PROF_STOP(2, lds, wid); PROF_START(3, lds, wid);
#pragma unroll
            for (int n = 0; n < 2; ++n) {
                *(PG8_LAS f32x4*)(HB + (wr * 16 + fr) * HBS + dl + 4 * n) = acc[0][0][3][n];
                if (wr == 0) *(PG8_LAS f32x4*)(HB + (32 + fr) * HBS + dl + 4 * n) = acc[1][0][3][n];
            }
            asm volatile("s_waitcnt lgkmcnt(0)" ::: "memory"); __builtin_amdgcn_s_barrier(); asm volatile("" ::: "memory");
            if (wr == 1) { asm volatile("s_waitcnt vmcnt(0)" ::: "memory"); if (lane == 0) __hip_atomic_fetch_add(myflag, 1u, __ATOMIC_RELAXED, __HIP_MEMORY_SCOPE_AGENT); }
            const int tpos0 = (u.pm * BM + rl) & 8191;
            const float fw = (float)(2 << g);
#define MIXB_RC(ai, m) (need ? (1.0f / fw) : 1.0f / fminf((float)(tpos0 + (ai) * HALF + (m) * 16 + 1), fw))
            PROF_STOP(3, lds, wid); PROF_START(4, lds, wid);
            u32x4 o[2][4];
            { f32x4 pv[2]; pv[0] = *(const PG8_LAS f32x4*)(HB + ((1 + wr) * 16 + fr) * HBS + dl); pv[1] = *(const PG8_LAS f32x4*)(HB + ((1 + wr) * 16 + fr) * HBS + dl + 4);
              o[1][0] = b_block(g, acc[1][0][0], pv, acc[1][1][0], MIXB_RC(1, 0), fr); }
#pragma unroll
            for (int m = 1; m < 4; ++m) o[1][m] = b_block(g, acc[1][0][m], acc[1][0][m - 1], acc[1][1][m], MIXB_RC(1, m), fr);
            PROF_STOP(4, lds, wid); PROF_START(5, lds, wid);
            f32x4 pvg[2]; pvg[0] = zero; pvg[1] = zero;
            if (wr == 1) { pvg[0] = *(const PG8_LAS f32x4*)(HB + fr * HBS + dl); pvg[1] = *(const PG8_LAS f32x4*)(HB + fr * HBS + dl + 4); }
            else if (need) { wait_flag(u, lane); pvg[0] = ld_sc1_f32x4(halo_in + fr * 128 + dl); pvg[1] = ld_sc1_f32x4(halo_in + fr * 128 + dl + 4); }
            PROF_STOP(5, lds, wid); PROF_START(6, lds, wid);
#pragma unroll
            for (int m = 1; m < 4; ++m) o[0][m] = b_block(g, acc[0][0][m], acc[0][0][m - 1], acc[0][1][m], MIXB_RC(0, m), fr);
            o[0][0] = b_block(g, acc[0][0][0], pvg, acc[0][1][0], MIXB_RC(0, 0), fr);
#undef MIXB_RC
            PROF_STOP(6, lds, wid); PROF_START(7, lds, wid);
            bf16_t* yp = Y + (size_t)row0 * 1024 + 512 + 128 * g + dl;
#pragma unroll
            for (int ai = 0; ai < 2; ++ai)
#pragma unroll
                for (int m = 0; m < 4; ++m) st_pay_u32x4(yp + (size_t)(ai * HALF + 16 * m) * 1024, o[ai][m]);
            PROF_STOP(7, lds, wid);
        }
    }
};

template <int MODE> struct EpiRms {
    static constexpr bool PERM = true, AFTER_DRAIN = true;
    const bf16_t* base_b; float* out_f; bf16_t* out_b; float* ssq_out; const float* gpost;
    unsigned long long* xslot; unsigned* tmo; unsigned tag;
    unsigned long long* xslot2; float* sa_out; signed char* xq;
    __device__ __forceinline__ void fused(f32x4 (&acc)[2][2][4][2], const Unit& u, int wr, int wc, int fr, int fq, PG8_LAS unsigned char* lds, int wid, int lane) const {
        PG8_LAS float* P = (PG8_LAS float*)lds;
        PG8_LAS float* S = (PG8_LAS float*)(lds + 4096);
        PG8_LAS float* PM = (PG8_LAS float*)(lds + 8192);
        PG8_LAS float* S2 = (PG8_LAS float*)(lds + 12288);
        PROF_START(30, lds, wid);
#pragma unroll
        for (int ai = 0; ai < 2; ++ai)
#pragma unroll
            for (int m = 0; m < 4; ++m) { float s = 0.f;
#pragma unroll
                for (int bj = 0; bj < 2; ++bj)
#pragma unroll
                    for (int n = 0; n < 2; ++n) { const f32x4 x = acc[ai][bj][m][n]; s += (x[0] * x[0] + x[1] * x[1]) + (x[2] * x[2] + x[3] * x[3]); }
                s += __shfl_xor(s, 16); s += __shfl_xor(s, 32);
                if (fq == 0) P[(ai * HALF + wr * 64 + m * 16 + fr) * 4 + wc] = s; }
        asm volatile("s_waitcnt lgkmcnt(0)" ::: "memory"); __builtin_amdgcn_s_barrier(); asm volatile("" ::: "memory");
        PROF_STOP(30, lds, wid); PROF_START(31, lds, wid);
        const int row = wid * 32 + (lane & 31);
        unsigned long long* slot = xslot + (size_t)(u.pm * BM + row) * 4;
        if (lane < 32) { const f32x4 p = *(const PG8_LAS f32x4*)(P + row * 4); const float t = (p[0] + p[1]) + (p[2] + p[3]);
            __hip_atomic_store(slot + u.pn, ((unsigned long long)tag << 32) | __float_as_uint(t), __ATOMIC_RELAXED, __HIP_MEMORY_SCOPE_AGENT); }
        const int col0 = u.pn * BM + wc * 32 + 8 * fq;
        const size_t off0 = (size_t)(u.pm * BM + wr * 64 + fr) * 1024 + col0;
        u32x4 rb[2][4][2];
#define RMS_LOAD_RES(ai) do { _Pragma("unroll") for (int m = 0; m < 4; ++m) _Pragma("unroll") for (int bj = 0; bj < 2; ++bj) \
            rb[ai][m][bj] = *(const u32x4*)(base_b + off0 + (size_t)((ai) * HALF + m * 16) * 1024 + bj * HALF); } while (0)
        RMS_LOAD_RES(0);
        f32x4 gv[2][2];
#pragma unroll
        for (int bj = 0; bj < 2; ++bj)
#pragma unroll
            for (int n = 0; n < 2; ++n) gv[bj][n] = *(const f32x4*)(gpost + col0 + bj * HALF + 4 * n);
        PROF_STOP(31, lds, wid); PROF_START(32, lds, wid);
        if (lane < 32) { float t = 0.f; unsigned sp = 0;
            for (;;) { bool ok = true; t = 0.f;
#pragma unroll
                for (int k = 0; k < 4; ++k) { const unsigned long long g = __hip_atomic_load(slot + k, __ATOMIC_RELAXED, __HIP_MEMORY_SCOPE_AGENT); ok &= ((unsigned)(g >> 32) == tag); t += __uint_as_float((unsigned)g); }
                if (ok) break;
                __builtin_amdgcn_s_sleep(1);
                if (++sp > (1u << 20)) { __hip_atomic_store(tmo, 0x700u | (unsigned)u.pm, __ATOMIC_RELAXED, __HIP_MEMORY_SCOPE_AGENT); break; } }
            S[row] = rsqrtf(t * (1.0f / 1024.0f) + 1e-6f); }
        asm volatile("s_waitcnt lgkmcnt(0)" ::: "memory"); __builtin_amdgcn_s_barrier(); asm volatile("" ::: "memory");
        PROF_STOP(32, lds, wid); PROF_START(33, lds, wid);
        u32x4 keep[2][4][2];
        RMS_LOAD_RES(1);
#undef RMS_LOAD_RES
        asm volatile("" ::: "memory");
#pragma unroll
        for (int ai = 0; ai < 2; ++ai)
#pragma unroll
            for (int m = 0; m < 4; ++m) { const int r = ai * HALF + wr * 64 + m * 16 + fr; const float iv = S[r]; const size_t off = off0 + (size_t)(ai * HALF + m * 16) * 1024; float q = 0.f, mx = 0.f;
#pragma unroll
                for (int bj = 0; bj < 2; ++bj) { const u32x4 bb = rb[ai][m][bj];
                    f32x4 b0, b1; b0[0] = __uint_as_float(bb.x << 16); b0[1] = __uint_as_float(bb.x & 0xffff0000u); b0[2] = __uint_as_float(bb.y << 16); b0[3] = __uint_as_float(bb.y & 0xffff0000u);
                    b1[0] = __uint_as_float(bb.z << 16); b1[1] = __uint_as_float(bb.z & 0xffff0000u); b1[2] = __uint_as_float(bb.w << 16); b1[3] = __uint_as_float(bb.w & 0xffff0000u);
                    const f32x4 o0 = b0 + acc[ai][bj][m][0] * iv * gv[bj][0], o1 = b1 + acc[ai][bj][m][1] * iv * gv[bj][1];
                    if (MODE == 0) { q += ((o0[0] * o0[0] + o0[1] * o0[1]) + (o0[2] * o0[2] + o0[3] * o0[3])) + ((o1[0] * o1[0] + o1[1] * o1[1]) + (o1[2] * o1[2] + o1[3] * o1[3]));
                        mx = fmaxf(mx, fmaxf(fmaxf(fmaxf(fabsf(o0[0]), fabsf(o0[1])), fmaxf(fabsf(o0[2]), fabsf(o0[3]))), fmaxf(fmaxf(fabsf(o1[0]), fabsf(o1[1])), fmaxf(fabsf(o1[2]), fabsf(o1[3])))));
                        u32x4 wv; wv.x = cvt_pk_bf16(o0[0], o0[1]); wv.y = cvt_pk_bf16(o0[2], o0[3]); wv.z = cvt_pk_bf16(o1[0], o1[1]); wv.w = cvt_pk_bf16(o1[2], o1[3]); st_pay_u32x4(out_b + off + bj * HALF, wv); keep[ai][m][bj] = wv; }
                    else { __builtin_nontemporal_store(o0, (f32x4*)(out_f + off + bj * HALF)); __builtin_nontemporal_store(o1, (f32x4*)(out_f + off + bj * HALF + 4)); } }
                if (MODE == 0) { q += __shfl_xor(q, 16); q += __shfl_xor(q, 32); mx = fmaxf(mx, __shfl_xor(mx, 16)); mx = fmaxf(mx, __shfl_xor(mx, 32)); if (fq == 0) { P[r * 4 + wc] = q; PM[r * 4 + wc] = mx; } } }
        PROF_STOP(33, lds, wid); PROF_START(34, lds, wid);
        if (MODE == 0) {
            asm volatile("s_waitcnt lgkmcnt(0)" ::: "memory"); __builtin_amdgcn_s_barrier(); asm volatile("" ::: "memory");
            if (lane < 32) { const f32x4 p = *(const PG8_LAS f32x4*)(P + row * 4); st_pay_f32(ssq_out + (size_t)(u.pm * BM + row) * 4 + u.pn, (p[0] + p[1]) + (p[2] + p[3])); }
            unsigned long long* slot2 = xslot2 + (size_t)(u.pm * BM + row) * 4;
            if (lane < 32) { const f32x4 pm4 = *(const PG8_LAS f32x4*)(PM + row * 4);
                __hip_atomic_store(slot2 + u.pn, ((unsigned long long)tag << 32) | __float_as_uint(fmaxf(fmaxf(pm4[0], pm4[1]), fmaxf(pm4[2], pm4[3]))), __ATOMIC_RELAXED, __HIP_MEMORY_SCOPE_AGENT);
                float rmx = 0.f; unsigned sp = 0;
                for (;;) { bool ok = true; rmx = 0.f;
#pragma unroll
                    for (int k = 0; k < 4; ++k) { const unsigned long long g = __hip_atomic_load(slot2 + k, __ATOMIC_RELAXED, __HIP_MEMORY_SCOPE_AGENT); ok &= ((unsigned)(g >> 32) == tag); rmx = fmaxf(rmx, __uint_as_float((unsigned)g)); }
                    if (ok) break;
                    __builtin_amdgcn_s_sleep(1);
                    if (++sp > (1u << 20)) { __hip_atomic_store(tmo, 0x780u | (unsigned)u.pm, __ATOMIC_RELAXED, __HIP_MEMORY_SCOPE_AGENT); break; } }
                rmx = fmaxf(rmx, 1e-30f); S2[row] = 127.0f / rmx;
                if (u.pn == 0) st_pay_f32(sa_out + (size_t)u.pm * BM + row, rmx * (1.0f / 127.0f)); }
            asm volatile("s_waitcnt lgkmcnt(0)" ::: "memory"); __builtin_amdgcn_s_barrier(); asm volatile("" ::: "memory");
#pragma unroll
            for (int ai = 0; ai < 2; ++ai)
#pragma unroll
                for (int m = 0; m < 4; ++m) { const int r = ai * HALF + wr * 64 + m * 16 + fr; const float qs = S2[r]; const size_t off = off0 + (size_t)(ai * HALF + m * 16) * 1024;
#pragma unroll
                    for (int bj = 0; bj < 2; ++bj) { const u32x4 bb = keep[ai][m][bj]; const unsigned w4[4] = {bb.x, bb.y, bb.z, bb.w}; unsigned f[8];
#pragma unroll
                        for (int i = 0; i < 4; ++i) { f[2 * i] = __float_as_uint(fmaf(__uint_as_float(w4[i] << 16), qs, 12582912.0f)); f[2 * i + 1] = __float_as_uint(fmaf(__uint_as_float(w4[i] & 0xffff0000u), qs, 12582912.0f)); }
                        u32x2 o; o.x = __builtin_amdgcn_perm(__builtin_amdgcn_perm(f[3], f[2], 0x0c0c0400u), __builtin_amdgcn_perm(f[1], f[0], 0x0c0c0400u), 0x05040100u);
                        o.y = __builtin_amdgcn_perm(__builtin_amdgcn_perm(f[7], f[6], 0x0c0c0400u), __builtin_amdgcn_perm(f[5], f[4], 0x0c0c0400u), 0x05040100u);
                        st_pay_u32x2(xq + off + bj * HALF, o); } }
        }
    }
};

template <class Epi, class Sched, bool ALIGN_EPI = false, bool SP2 = false, bool I8 = false>
__device__ __forceinline__ void gemm_phase(PG8_LAS unsigned char* lds, const Gemm g, const Sched& S, const Epi& E) {
    const int tid = threadIdx.x, wid = __builtin_amdgcn_readfirstlane(tid >> 6), lane = tid & 63, wr = wid >> 2, wc = wid & 3, fr = lane & 15, fq = lane >> 4;
    const int K = g.K, nt = K / BK;
    unsigned voffA[2], voffB[2];
#pragma unroll
    for (int i = 0; i < 2; ++i) { int R, C; stage_rc(tid * 16 + i * 8192, R, C); const int Rb = Epi::PERM ? ((R & ~31) + perm32(R & 31)) : R;
        voffA[i] = (unsigned)(R * K + C) * 2u; voffB[i] = (unsigned)(Rb * K + C) * 2u; }
    const size_t kstep = (size_t)(BK * 2);
    const size_t hstep = (size_t)HALF * K * 2;
    const size_t tstep = 2 * hstep;
    const unsigned ldsw = (unsigned)wid * 1024u;
    const int aoff = lds_byte(wr * 64 + fr, fq * 8), boff = lds_byte(wc * 32 + fr, fq * 8);
#define PG8_SA(b, h) (((b) * 2 + (h)) * HTB)
#define PG8_SB(b, h) ((4 + (b) * 2 + (h)) * HTB)
#define PG8_STAGE(bufoff, gbase, voff) do { _Pragma("unroll") for (int _i = 0; _i < 2; ++_i) \
        __builtin_amdgcn_global_load_lds((const unsigned*)((const char*)(gbase) + (voff)[_i]), (PG8_LAS unsigned*)(lds + (bufoff) + ldsw + _i * 8192), 16, 0, 0); } while (0)
#define PG8_LDA(dst, b, h) do { _Pragma("unroll") for (int m = 0; m < 4; ++m) _Pragma("unroll") for (int k = 0; k < 2; ++k) dst[m][k] = *(const PG8_LAS bf16x8*)(lds + PG8_SA(b, h) + aoff + m * 2048 + k * 1024); } while (0)
#define PG8_LDB(dst, b, h) do { _Pragma("unroll") for (int n = 0; n < 2; ++n) _Pragma("unroll") for (int k = 0; k < 2; ++k) dst[n][k] = *(const PG8_LAS bf16x8*)(lds + PG8_SB(b, h) + boff + n * 2048 + k * 1024); } while (0)
#define PG8_MMA(ai, bj, At, Bt) do { __builtin_amdgcn_s_setprio(1); _Pragma("unroll") for (int m = 0; m < 4; ++m) _Pragma("unroll") for (int n = 0; n < 2; ++n) _Pragma("unroll") for (int k = 0; k < 2; ++k) \
        { if constexpr (I8) acc[ai][bj][m][n] = __builtin_bit_cast(f32x4, __builtin_amdgcn_mfma_i32_16x16x64_i8(__builtin_bit_cast(i32x4, Bt[n][k]), __builtin_bit_cast(i32x4, At[m][k]), __builtin_bit_cast(i32x4, acc[ai][bj][m][n]), 0, 0, 0)); \
          else acc[ai][bj][m][n] = __builtin_amdgcn_mfma_f32_16x16x32_bf16(Bt[n][k], At[m][k], acc[ai][bj][m][n], 0, 0, 0); } __builtin_amdgcn_s_setprio(0); } while (0)
#define PG8_WAIT_V(n) asm volatile("s_waitcnt vmcnt(" #n ")" ::: "memory")
#define PG8_WAIT_L(n) asm volatile("s_waitcnt lgkmcnt(" #n ")" ::: "memory")
#define PG8_BAR __builtin_amdgcn_s_barrier()
#define PG8_SCHED __builtin_amdgcn_sched_barrier(0)
    PROF_START(22, lds, wid);
    Unit cur, nxt; int ui = 0;
    if (!S.next(0, cur)) return;
    f32x4 acc[2][2][4][2];
#pragma unroll
    for (int a = 0; a < 2; ++a)
#pragma unroll
        for (int b = 0; b < 2; ++b)
#pragma unroll
            for (int m = 0; m < 4; ++m)
#pragma unroll
                for (int n = 0; n < 2; ++n) acc[a][b][m][n] = (f32x4){0.f, 0.f, 0.f, 0.f};
    bf16x8 At[4][2], B0[2][2], B1[2][2];
    const char* cA = (const char*)g.A + (size_t)cur.pm * tstep; const char* cB = (const char*)g.Bt + (size_t)cur.pn * tstep;
    S.a_ready(cur);
    if constexpr (SP2) {
        PG8_STAGE(PG8_SB(0, 0), cB, voffB); PG8_STAGE(PG8_SB(0, 1), cB + hstep, voffB); PG8_STAGE(PG8_SA(0, 0), cA, voffA); PG8_STAGE(PG8_SA(0, 1), cA + hstep, voffA);
        if (wr == 1) PG8_BAR;
        PG8_WAIT_V(2); PG8_BAR;
        PG8_STAGE(PG8_SB(1, 0), cB + kstep, voffB); PG8_STAGE(PG8_SA(1, 0), cA + kstep, voffA); PG8_STAGE(PG8_SB(1, 1), cB + hstep + kstep, voffB);
        PG8_WAIT_V(6); PG8_BAR;
    } else {
        PG8_STAGE(PG8_SB(0, 0), cB, voffB); PG8_STAGE(PG8_SA(0, 0), cA, voffA); PG8_STAGE(PG8_SB(0, 1), cB + hstep, voffB); PG8_STAGE(PG8_SA(0, 1), cA + hstep, voffA);
        if (wr == 1) PG8_BAR;
        PG8_WAIT_V(4); PG8_BAR;
        PG8_STAGE(PG8_SB(1, 0), cB + kstep, voffB); PG8_STAGE(PG8_SA(1, 0), cA + kstep, voffA); PG8_STAGE(PG8_SB(1, 1), cB + hstep + kstep, voffB);
        PG8_WAIT_V(6); PG8_BAR;
    }
    PROF_STOP(22, lds, wid);
    for (;;) {
        const bool has_next = S.next(ui + 1, nxt);
        const char* nA = has_next ? (const char*)g.A + (size_t)nxt.pm * tstep : cA; const char* nB = has_next ? (const char*)g.Bt + (size_t)nxt.pn * tstep : cB;
        PROF_START(8, lds, wid);
        asm volatile(".p2align 8");
        for (int t = 0; t < nt; t += 2) {
            const bool last = (t == nt - 2);
            const char* a1 = cA + (size_t)(t + 1) * kstep;
            const char* a2 = last ? nA : cA + (size_t)(t + 2) * kstep; const char* b2 = last ? nB : cB + (size_t)(t + 2) * kstep;
            const char* a3 = a2 + kstep; const char* b3 = b2 + kstep;
            if (last && has_next) S.a_ready(nxt);
            if constexpr (SP2) {
            PG8_LDB(B0, 0, 0); PG8_LDB(B1, 0, 1); PG8_SCHED; PG8_LDA(At, 0, 0); PG8_STAGE(PG8_SA(1, 1), a1 + hstep, voffA);
            PG8_WAIT_V(8); PG8_WAIT_L(0); PG8_BAR; PG8_MMA(0, 0, At, B0); PG8_MMA(0, 1, At, B1); PG8_BAR; PG8_SCHED;
            PG8_LDA(At, 0, 1); PG8_STAGE(PG8_SB(0, 0), b2, voffB); PG8_STAGE(PG8_SB(0, 1), b2 + hstep, voffB); PG8_STAGE(PG8_SA(0, 0), a2, voffA);
            PG8_WAIT_V(8); PG8_WAIT_L(0); PG8_BAR; PG8_MMA(1, 0, At, B0); PG8_MMA(1, 1, At, B1); PG8_BAR; PG8_SCHED;
            PG8_LDB(B0, 1, 0); PG8_LDB(B1, 1, 1); PG8_SCHED; PG8_LDA(At, 1, 0); PG8_STAGE(PG8_SA(0, 1), a2 + hstep, voffA);
            PG8_WAIT_V(8); PG8_WAIT_L(0); PG8_BAR; PG8_MMA(0, 0, At, B0); PG8_MMA(0, 1, At, B1); PG8_BAR; PG8_SCHED;
            PG8_LDA(At, 1, 1); PG8_STAGE(PG8_SB(1, 0), b3, voffB); PG8_STAGE(PG8_SB(1, 1), b3 + hstep, voffB); PG8_STAGE(PG8_SA(1, 0), a3, voffA);
            PG8_WAIT_V(8); PG8_WAIT_L(0); PG8_BAR; PG8_MMA(1, 0, At, B0); PG8_MMA(1, 1, At, B1); PG8_BAR; PG8_SCHED;
            } else {
            PG8_LDB(B0, 0, 0); PG8_SCHED; PG8_LDA(At, 0, 0); PG8_STAGE(PG8_SA(1, 1), a1 + hstep, voffA);
            PG8_WAIT_L(8); PG8_BAR; PG8_WAIT_L(0); PG8_MMA(0, 0, At, B0); PG8_BAR; PG8_SCHED;
            PG8_LDB(B1, 0, 1); PG8_STAGE(PG8_SB(0, 0), b2, voffB);
            PG8_BAR; PG8_WAIT_L(0); PG8_MMA(0, 1, At, B1); PG8_BAR;
            PG8_LDA(At, 0, 1); PG8_STAGE(PG8_SA(0, 0), a2, voffA);
            PG8_BAR; PG8_WAIT_L(0); PG8_MMA(1, 0, At, B0); PG8_BAR; PG8_SCHED;
            PG8_STAGE(PG8_SB(0, 1), b2 + hstep, voffB);
            PG8_WAIT_V(6); PG8_BAR; PG8_MMA(1, 1, At, B1); PG8_BAR;
            PG8_LDB(B0, 1, 0); PG8_SCHED; PG8_LDA(At, 1, 0); PG8_STAGE(PG8_SA(0, 1), a2 + hstep, voffA);
            PG8_WAIT_L(8); PG8_BAR; PG8_WAIT_L(0); PG8_MMA(0, 0, At, B0); PG8_BAR; PG8_SCHED;
            PG8_LDB(B1, 1, 1); PG8_STAGE(PG8_SB(1, 0), b3, voffB);
            PG8_BAR; PG8_WAIT_L(0); PG8_MMA(0, 1, At, B1); PG8_BAR;
            PG8_LDA(At, 1, 1); PG8_STAGE(PG8_SA(1, 0), a3, voffA);
            PG8_BAR; PG8_WAIT_L(0); PG8_MMA(1, 0, At, B0); PG8_BAR; PG8_SCHED;
            PG8_STAGE(PG8_SB(1, 1), b3 + hstep, voffB);
            PG8_WAIT_V(6); PG8_BAR; PG8_MMA(1, 1, At, B1); PG8_BAR;
            }
        }
        PROF_STOP(8, lds, wid); PROF_START(14, lds, wid);
        if constexpr (ALIGN_EPI) { if (wr == 0) PG8_BAR; }
        PROF_STOP(14, lds, wid); PROF_START(1, lds, wid);
        if constexpr (!Epi::AFTER_DRAIN) { E(acc, cur, wr, wc, fr, fq, lds, wid, lane); S.done(cur); }
        PROF_STOP(1, lds, wid);
        if (!has_next) break;
#pragma unroll
        for (int a = 0; a < 2; ++a)
#pragma unroll
            for (int b = 0; b < 2; ++b)
#pragma unroll
                for (int m = 0; m < 4; ++m)
#pragma unroll
                    for (int n = 0; n < 2; ++n) acc[a][b][m][n] = (f32x4){0.f, 0.f, 0.f, 0.f};
        cur = nxt; cA = nA; cB = nB; ++ui;
        if constexpr (ALIGN_EPI) { if (wr == 1) PG8_BAR; }
    }
    PROF_START(23, lds, wid);
    PG8_WAIT_V(0);
    if constexpr (!ALIGN_EPI) { if (wr == 0) PG8_BAR; }
    PG8_BAR;
    PROF_STOP(23, lds, wid); PROF_START(11, lds, wid);
    if constexpr (Epi::AFTER_DRAIN) { E.fused(acc, cur, wr, wc, fr, fq, lds, wid, lane); S.done(cur); }
    PROF_STOP(11, lds, wid);
#undef PG8_SA
#undef PG8_SB
#undef PG8_STAGE
#undef PG8_LDA
#undef PG8_LDB
#undef PG8_MMA
#undef PG8_WAIT_V
#undef PG8_WAIT_L
#undef PG8_BAR
#undef PG8_SCHED
}
}

constexpr int NWAVES = 8;
#ifndef MK_N_LAUNCHES
#define MK_N_LAUNCHES 1
#endif
constexpr int N_LAUNCHES = MK_N_LAUNCHES;
constexpr int N_PHASES = 5;

constexpr int D = 1024, BATCH = 2, SEQ = 8192, DEPTH = 2, M = BATCH * SEQ, NIN = 3072;
constexpr size_t MiB = 1u << 20;
constexpr size_t WS_CTL = 0, CTL_ZERO_BYTES = 192 * 1024;
constexpr size_t WS_W1T = 2 * MiB;
constexpr size_t WS_W2T = 14 * MiB;
constexpr size_t WS_SSQ = 18 * MiB;
constexpr size_t WS_XSLOT = 19 * MiB;
constexpr size_t WS_HALO = 20 * MiB;
constexpr size_t WS_XB = 32 * MiB;
constexpr size_t WS_Y = 64 * MiB;
constexpr size_t WS_HGA = 96 * MiB;
constexpr size_t WS_W1Q = 97 * MiB;
constexpr size_t WS_SW = 100 * MiB;
constexpr size_t WS_XQ = 101 * MiB;
constexpr size_t WS_SA = 117 * MiB;
constexpr size_t WS_XS2 = 118 * MiB;
constexpr size_t WS_END = 119 * MiB;
constexpr int CW_TMO = 0, CW_BAR = 4096, CW_CNT = 8192, CW_XCC = 12288, CW_FLAG = 16384, CW_CMAX = 40960  , CW_QCNT = 44160  ;
static_assert(CW_FLAG + 2 * 768 * 16 <= CW_CMAX && (CW_QCNT + 64) * 4 <= (int)CTL_ZERO_BYTES && (CW_FLAG + 2 * 768 * 16) * 4 <= (int)CTL_ZERO_BYTES, "ctl words inside the memset region");

constexpr int RING_BYTES = 131072;
constexpr int HB_OFF = RING_BYTES;
constexpr int MISC_OFF = pg8::EPI_MISC_OFF;
constexpr int LDS_BYTES = pg8::EPI_LDS_END;
constexpr int SCR_STRIDE = 17408;
static_assert(pg8::HB_BYTES <= 25600 && 8 * SCR_STRIDE <= MISC_OFF && LDS_BYTES <= 160 * 1024, "LDS map");

#define GAS __attribute__((address_space(1)))
#define LAS __attribute__((address_space(3)))
typedef unsigned short bf16;
typedef unsigned v4u __attribute__((ext_vector_type(4)));
typedef unsigned v2u __attribute__((ext_vector_type(2)));
typedef float f32x4 __attribute__((ext_vector_type(4)));
typedef float f32x16 __attribute__((ext_vector_type(16)));
#define LDS_WAIT() asm volatile("s_waitcnt lgkmcnt(0)" ::: "memory")
#define VM_WAIT() asm volatile("s_waitcnt vmcnt(0)" ::: "memory")
__device__ __forceinline__ unsigned f2bf(float f) { unsigned u = __builtin_bit_cast(unsigned, f); return (u + 0x7fffu + ((u >> 16) & 1u)) >> 16; }
__device__ __forceinline__ unsigned pk2(float lo, float hi) { return f2bf(lo) | (f2bf(hi) << 16); }

#define XB_TMO      128
#define XB_XCNT(j)  (256  + 64 * (j))
#define XB_XSUB(j)  (1280 + 64 * (j))
#define XB_XGEN(j)  (2304 + 64 * (j))
#define XB_TOP      3328
#define XB_TOPGEN   3392
#define XCD_BAR_WORDS 3456
#define XB_SPIN_CAP (1u << 18)

__device__ __forceinline__ unsigned xb_ld(unsigned* p)              { return __hip_atomic_load(p, __ATOMIC_RELAXED, __HIP_MEMORY_SCOPE_AGENT); }
__device__ __forceinline__ unsigned xb_add(unsigned* p, unsigned v) { return __hip_atomic_fetch_add(p, v, __ATOMIC_RELAXED, __HIP_MEMORY_SCOPE_AGENT); }
__device__ __forceinline__ unsigned xb_xcc_id() { return (unsigned)__builtin_amdgcn_s_getreg((3 << 11) | 20) & 0xFu; }
#define XB_SPIN(cond, bar) do { unsigned _sp = 0; while (cond) { __builtin_amdgcn_s_sleep(1); \
    if ((++_sp & 255u) == 0u) { if (xb_ld(&(bar)[XB_TMO])) break; if (_sp > XB_SPIN_CAP) { atomicAdd(&(bar)[XB_TMO], 1u); break; } } } } while (0)

struct XcdBarrier {
    unsigned* bar; unsigned x;
    volatile LAS unsigned* st;
};

__device__ __forceinline__ XcdBarrier xcd_barrier_post(unsigned* bar, volatile LAS unsigned* st) {
    XcdBarrier b; b.bar = bar; b.x = xb_xcc_id(); b.st = st;
    if (threadIdx.x == 0) (void)xb_add(&bar[XB_XCNT(b.x)], 1u);
    return b;
}
__device__ __forceinline__ void xcd_barrier_complete(unsigned* bar, unsigned x, unsigned& nloc, unsigned& nx) {
    const unsigned G = gridDim.x * gridDim.y * gridDim.z;
    unsigned sum, cnt, mine, sp = 0u;
    for (;;) {
        sum = 0u; cnt = 0u; mine = 0u;
#pragma unroll
        for (unsigned j = 0; j < 16; ++j) { const unsigned c = xb_ld(&bar[XB_XCNT(j)]); sum += c; cnt += (c > 0u) ? 1u : 0u; mine = (j == x) ? c : mine; }
        if (sum == G) break;
        __builtin_amdgcn_s_sleep(1);
        if ((++sp & 255u) == 0u) { if (xb_ld(&bar[XB_TMO])) break; if (sp > XB_SPIN_CAP) { atomicAdd(&bar[XB_TMO], 1u); break; } }
    }
    nloc = mine > 0u ? mine : 1u; nx = cnt > 0u ? cnt : 1u;
}

__device__ __forceinline__ void xcd_barrier(const XcdBarrier& b, bool leader_wb = true, bool self_wb = false) {
    asm volatile("s_waitcnt vmcnt(0)" ::: "memory");
    __syncthreads();
    if (threadIdx.x == 0) {
        unsigned* bar = b.bar;
        if (self_wb) { __builtin_amdgcn_fence(__ATOMIC_RELEASE, "agent"); asm volatile("s_waitcnt vmcnt(0)" ::: "memory"); }
        __builtin_amdgcn_s_waitcnt(0);
        unsigned nloc = b.st[0], nx = b.st[1];
        if (nloc == 0u) { xcd_barrier_complete(bar, b.x, nloc, nx); b.st[0] = nloc; b.st[1] = nx; }
        const unsigned old = xb_add(&bar[XB_XSUB(b.x)], 1u);
        const unsigned gen = old / nloc;
        if (old + 1u == (gen + 1u) * nloc) {
            if (leader_wb) __builtin_amdgcn_fence(__ATOMIC_RELEASE, "agent");
            asm volatile("s_waitcnt vmcnt(0)" ::: "memory");
            const unsigned og = xb_add(&bar[XB_TOP], 1u);
            const unsigned tg = og / nx;
            if (og + 1u == (tg + 1u) * nx) xb_add(&bar[XB_TOPGEN], 1u);
            else XB_SPIN(xb_ld(&bar[XB_TOPGEN]) == tg, bar);
            __builtin_amdgcn_fence(__ATOMIC_ACQUIRE, "agent");
            xb_add(&bar[XB_XGEN(b.x)], 1u);
            asm volatile("s_waitcnt vmcnt(0)" ::: "memory");
        } else {
            XB_SPIN(xb_ld(&bar[XB_XGEN(b.x)]) == gen, bar);
            __builtin_amdgcn_fence(__ATOMIC_ACQUIRE, "agent");
            asm volatile("s_waitcnt vmcnt(0)" ::: "memory");
        }
    }
    __syncthreads();
}


__device__ __forceinline__ void seam_arrive(unsigned* word, bool fence) {
    asm volatile("s_waitcnt vmcnt(0)" ::: "memory");
    __syncthreads();
    if (threadIdx.x == 0) {
        if (fence) { __builtin_amdgcn_fence(__ATOMIC_RELEASE, "agent"); asm volatile("s_waitcnt vmcnt(0)" ::: "memory"); }
        (void)__hip_atomic_fetch_add(word, 1u, __ATOMIC_RELAXED, __HIP_MEMORY_SCOPE_AGENT);
    }
}
__device__ __forceinline__ void seam_wait(unsigned* word, unsigned want, unsigned* tmo, unsigned code) {
    if (threadIdx.x < 64) { unsigned sp = 0;
        __builtin_amdgcn_fence(__ATOMIC_ACQUIRE, "agent");
        while ((unsigned)__builtin_amdgcn_readfirstlane(__hip_atomic_load(word, __ATOMIC_RELAXED, __HIP_MEMORY_SCOPE_AGENT)) < want) { __builtin_amdgcn_s_sleep(1);
            if (++sp > (1u << 20)) { if (threadIdx.x == 0) __hip_atomic_store(tmo, code, __ATOMIC_RELAXED, __HIP_MEMORY_SCOPE_AGENT); break; } }
        asm volatile("s_waitcnt vmcnt(0)" ::: "memory"); }
    __syncthreads();
}

__device__ __forceinline__ float wave_sum(float v) {
#pragma unroll
    for (int o = 1; o < 64; o <<= 1) v += __shfl_xor(v, o);
    return v;
}
__device__ __forceinline__ int w1_srccol(int n) {
    const int pn = n >> 8, c = n & 255, bj = c >> 7, wc = (c >> 5) & 3, nn = (c >> 4) & 1, fq = (c >> 2) & 3, j = c & 3;
    if (pn < 8) return (2 * bj + nn) * 512 + 64 * pn + 16 * wc + 4 * fq + j;
    if (bj == 0) return -1;
    return 2560 + 128 * (pn - 8) + 32 * wc + 8 * fq + 4 * nn + j;
}
struct TrItem { const float* W; const float* gs; bf16* WT; unsigned* cmax; int ldw, n0, srccol, k0; };
__device__ __forceinline__ void tr_load(const TrItem& d, int lane, float (&v)[32]) {
#pragma unroll
    for (int i = 0; i < 32; ++i) v[i] = __builtin_nontemporal_load(d.W + (size_t)(d.k0 + 2 * i + (lane >> 5)) * d.ldw + d.srccol);
}
__device__ __forceinline__ void tr_finish(const TrItem& d, const float (&v)[32], LAS float* scr, int lane) {
    const int c = lane & 7;
    f32x4 g0 = {1.f, 1.f, 1.f, 1.f}, g1 = g0;
    if (d.gs) { g0 = *(const f32x4*)(d.gs + d.k0 + 8 * c); g1 = *(const f32x4*)(d.gs + d.k0 + 8 * c + 4); }
#pragma unroll
    for (int i = 0; i < 32; ++i) scr[(2 * i + (lane >> 5)) * 33 + (lane & 31)] = v[i];
    LDS_WAIT(); asm volatile("" ::: "memory");
#pragma unroll
    for (int j = 0; j < 4; ++j) { const int n = (lane >> 3) + 8 * j; const LAS float* s = scr + (8 * c) * 33 + n;
        v4u o; o.x = pk2(s[0 * 33] * g0[0], s[1 * 33] * g0[1]); o.y = pk2(s[2 * 33] * g0[2], s[3 * 33] * g0[3]); o.z = pk2(s[4 * 33] * g1[0], s[5 * 33] * g1[1]); o.w = pk2(s[6 * 33] * g1[2], s[7 * 33] * g1[3]);
        asm volatile("global_store_dwordx4 %0, %1, off sc1\n\ts_nop 1" :: "v"(d.WT + (size_t)(d.n0 + n) * D + d.k0 + 8 * c), "v"(o) : "memory");
        if (d.cmax) { float mx = fmaxf(fmaxf(fmaxf(fabsf(s[0 * 33] * g0[0]), fabsf(s[1 * 33] * g0[1])), fmaxf(fabsf(s[2 * 33] * g0[2]), fabsf(s[3 * 33] * g0[3]))), fmaxf(fmaxf(fabsf(s[4 * 33] * g1[0]), fabsf(s[5 * 33] * g1[1])), fmaxf(fabsf(s[6 * 33] * g1[2]), fabsf(s[7 * 33] * g1[3]))));
            mx = fmaxf(mx, __shfl_xor(mx, 1)); mx = fmaxf(mx, __shfl_xor(mx, 2)); mx = fmaxf(mx, __shfl_xor(mx, 4));
            if (c == 0) atomicMax(d.cmax + d.n0 + n, __float_as_uint(mx)); } }
    LDS_WAIT(); asm volatile("" ::: "memory");
}
__device__ __forceinline__ void p0_pool_item(const float* win, const float* gpre, const float* wpool, bf16* W1T, unsigned* cmax, LAS float* scr, int item, int lane) {
    const int db = item & 3, g = (item >> 2) & 3, kb = item >> 4;
    const int k0 = 32 * kb, d0 = 32 * db, i = lane & 31, h = lane >> 5;
    float b[64];
#pragma unroll
    for (int s = 0; s < 64; ++s) b[s] = wpool[(size_t)(g * 128 + 2 * s + h) * 128 + d0 + i];
#pragma unroll
    for (int r = 0; r < 16; ++r) { const int kk = 2 * r + h; const f32x4 v = *(const f32x4*)(win + (size_t)(k0 + kk) * NIN + 2048 + 128 * g + 4 * i); const float gs = gpre[k0 + kk];
        LAS float* d = scr + kk * 129 + 4 * i; d[0] = v[0] * gs; d[1] = v[1] * gs; d[2] = v[2] * gs; d[3] = v[3] * gs; }
    LDS_WAIT(); asm volatile("" ::: "memory");
    f32x16 acc;
#pragma unroll
    for (int r = 0; r < 16; ++r) acc[r] = 0.f;
#pragma unroll
    for (int s = 0; s < 64; ++s) { const float a = scr[i * 129 + 2 * s + h]; acc = __builtin_amdgcn_mfma_f32_32x32x2f32(a, b[s], acc, 0, 0, 0); }
    const int d = d0 + i, n = 256 * (8 + g) + 32 * (d >> 5) + 16 * ((d >> 2) & 1) + 4 * ((d >> 3) & 3) + (d & 3);
#pragma unroll
    for (int q = 0; q < 4; ++q) { v2u o; o.x = pk2(acc[4 * q + 0], acc[4 * q + 1]); o.y = pk2(acc[4 * q + 2], acc[4 * q + 3]); __hip_atomic_store((unsigned long long*)(W1T + (size_t)n * D + k0 + 8 * q + 4 * h), ((unsigned long long)o.y << 32) | o.x, __ATOMIC_RELAXED, __HIP_MEMORY_SCOPE_AGENT); }
    if (cmax) { float mx = 0.f;
#pragma unroll
        for (int r = 0; r < 16; ++r) mx = fmaxf(mx, fabsf(acc[r]));
        mx = fmaxf(mx, __shfl_xor(mx, 32)); if (h == 0) atomicMax(cmax + n, __float_as_uint(mx)); }
    LDS_WAIT(); asm volatile("" ::: "memory");
}

struct Args { const float* in[9]; float* out; unsigned char* ws; int ph_lo, ph_hi; };

__device__ __forceinline__ void p0_prologue(const Args& a, LAS unsigned char* lds, int gw, int NGW, int wave, int lane) {
    LAS float* scr = (LAS float*)(lds + wave * SCR_STRIDE);
    const float* x = a.in[0]; const float* pre_norm = a.in[1]; const float* w_in = a.in[2]; const float* w_pool = a.in[5]; const float* w_out = a.in[7];
    bf16* W1T = (bf16*)(a.ws + WS_W1T); bf16* W2T = (bf16*)(a.ws + WS_W2T); bf16* XB = (bf16*)(a.ws + WS_XB); float* SSQ = (float*)(a.ws + WS_SSQ);
    constexpr int I_POOL = DEPTH * 512, I_W1 = DEPTH * 80 * 16, I_W2 = DEPTH * 32 * 16, I_TR = I_W1 + I_W2;
    unsigned* cmax = (unsigned*)(a.ws + WS_CTL) + CW_CMAX;
    { unsigned long long* xs = (unsigned long long*)(a.ws + WS_XSLOT);
      for (int i = gw * 64 + lane; i < DEPTH * M * 4; i += NGW * 64) __hip_atomic_store(xs + i, 0ull, __ATOMIC_RELAXED, __HIP_MEMORY_SCOPE_AGENT);
      unsigned long long* x2 = (unsigned long long*)(a.ws + WS_XS2);
      for (int i = gw * 64 + lane; i < M * 4; i += NGW * 64) __hip_atomic_store(x2 + i, 0ull, __ATOMIC_RELAXED, __HIP_MEMORY_SCOPE_AGENT);
      unsigned long long* hz = (unsigned long long*)(a.ws + WS_HGA);
      for (int i = gw * 64 + lane; i < DEPTH * 8 * 64 * 128; i += NGW * 64) __hip_atomic_store(hz + i, 0ull, __ATOMIC_RELAXED, __HIP_MEMORY_SCOPE_AGENT); }
#define P0_TR_DESC(d, r_) do { int r = (r_); \
        if (r < I_W1) { const int l = r / 1280, q = r % 1280, nbi = q % 80, kb = q / 80;     \
            const int n0 = nbi < 64 ? 32 * nbi : 256 * (8 + ((nbi - 64) >> 2)) + 128 + 32 * ((nbi - 64) & 3); \
            d.W = w_in + (size_t)l * D * NIN; d.gs = pre_norm + l * D; d.WT = W1T + (size_t)l * NIN * D; d.cmax = l ? cmax : nullptr; d.ldw = NIN; d.n0 = n0; d.srccol = w1_srccol(n0 + (lane & 31)); d.k0 = 64 * kb; } \
        else { r -= I_W1; const int l = r >> 9, q = r & 511, nb = q & 31, kb = q >> 5; \
            d.W = w_out + (size_t)l * D * D; d.gs = nullptr; d.WT = W2T + (size_t)l * D * D; d.cmax = nullptr; d.ldw = D; d.n0 = 32 * nb; d.srccol = 32 * nb + (lane & 31); d.k0 = 64 * kb; } } while (0)
    if (NGW == 2048) {
        if (gw < I_POOL) {
            TrItem d; float v[32]; const bool has = gw < I_TR - 3 * 1024;
            if (has) { P0_TR_DESC(d, 3 * 1024 + gw); tr_load(d, lane, v); }
            { const int l = gw >> 9; p0_pool_item(w_in + (size_t)l * D * NIN, pre_norm + l * D, w_pool + (size_t)l * 4 * 128 * 128, W1T + (size_t)l * NIN * D, l ? cmax : nullptr, scr, gw & 511, lane); }
            if (has) tr_finish(d, v, scr, lane);
        } else {
            TrItem d0, d1, d2; float v0[32], v1[32], v2[32]; const int t0 = (gw - 1024) * 3;
            P0_TR_DESC(d0, t0); tr_load(d0, lane, v0); P0_TR_DESC(d1, t0 + 1); tr_load(d1, lane, v1); P0_TR_DESC(d2, t0 + 2); tr_load(d2, lane, v2);
            tr_finish(d0, v0, scr, lane); tr_finish(d1, v1, scr, lane); tr_finish(d2, v2, scr, lane);
        }
    } else {
        for (int it = gw; it < I_POOL + I_TR; it += NGW) {
            if (it < I_POOL) { const int l = it >> 9; p0_pool_item(w_in + (size_t)l * D * NIN, pre_norm + l * D, w_pool + (size_t)l * 4 * 128 * 128, W1T + (size_t)l * NIN * D, l ? cmax : nullptr, scr, it & 511, lane); }
            else { TrItem d; float v[32]; P0_TR_DESC(d, it - I_POOL); tr_load(d, lane, v); tr_finish(d, v, scr, lane); }
        }
    }
#undef P0_TR_DESC
    const int xstep = (NGW == 2048) ? 1 : NGW, xc = gw >> 3;
    const int xfirst = (NGW == 2048) ? (8 * (xc & 7) + ((xc >> 3) & 7)) * 256 + (xc >> 6) * 64 + (gw & 7) * 8 : gw, xend = (NGW == 2048) ? xfirst + 8 : M;
    for (int r0 = xfirst; r0 < xend; r0 += 4 * xstep) {
        f32x4 v[4][4];
#pragma unroll
        for (int q = 0; q < 4; ++q) { const f32x4* xr = (const f32x4*)(x + (size_t)(r0 + q * xstep) * D) + lane;
#pragma unroll
            for (int j = 0; j < 4; ++j) v[q][j] = (r0 + q * xstep < M) ? __builtin_nontemporal_load(xr + 64 * j) : (f32x4){0.f, 0.f, 0.f, 0.f}; }
#pragma unroll
        for (int q = 0; q < 4; ++q) { const int r = r0 + q * xstep; if (r >= M) break; float s = 0.f;
#pragma unroll
            for (int j = 0; j < 4; ++j) s += (v[q][j][0] * v[q][j][0] + v[q][j][1] * v[q][j][1]) + (v[q][j][2] * v[q][j][2] + v[q][j][3] * v[q][j][3]);
            s = wave_sum(s);
            if (lane == 0) *(f32x4*)(SSQ + (size_t)r * 4) = (f32x4){s, 0.f, 0.f, 0.f};
            v2u* o8 = (v2u*)(XB + (size_t)r * D) + lane;
#pragma unroll
            for (int j = 0; j < 4; ++j) { v2u o; o.x = pk2(v[q][j][0], v[q][j][1]); o.y = pk2(v[q][j][2], v[q][j][3]); o8[64 * j] = o; } }
    }
}

__device__ __forceinline__ void p0_quantize_w1(const Args& a, int gw, int NGW, int lane) {
    const bf16* W1T1 = (const bf16*)(a.ws + WS_W1T) + (size_t)NIN * D; signed char* W1Q = (signed char*)(a.ws + WS_W1Q); float* SW = (float*)(a.ws + WS_SW);
    unsigned* ctl = (unsigned*)(a.ws + WS_CTL);
    for (int n = gw; n < NIN; n += NGW) {
        const float cm = fmaxf(__uint_as_float(__hip_atomic_load(ctl + CW_CMAX + n, __ATOMIC_RELAXED, __HIP_MEMORY_SCOPE_AGENT)), 1e-30f), qs = 127.0f / cm;
        const v4u p0 = *(const v4u*)(W1T1 + (size_t)n * D + 16 * lane), p1 = *(const v4u*)(W1T1 + (size_t)n * D + 16 * lane + 8);
        const unsigned w[8] = {p0.x, p0.y, p0.z, p0.w, p1.x, p1.y, p1.z, p1.w}; unsigned o[4];
#pragma unroll
        for (int i = 0; i < 4; ++i) { unsigned r = 0u;
#pragma unroll
            for (int j = 0; j < 2; ++j) { const unsigned ww = w[2 * i + j]; const float lo = __uint_as_float(ww << 16) * qs, hi = __uint_as_float(ww & 0xffff0000u) * qs;
                const int ql = max(-127, min(127, (int)rintf(lo))), qh = max(-127, min(127, (int)rintf(hi)));
                r |= ((unsigned)(ql & 0xff) | ((unsigned)(qh & 0xff) << 8)) << (16 * j); }
            o[i] = r; }
        const v4u ov = {o[0], o[1], o[2], o[3]};
        asm volatile("global_store_dwordx4 %0, %1, off sc1\n\ts_nop 1" :: "v"(W1Q + (size_t)n * D + 16 * lane), "v"(ov) : "memory");
        if (lane == 0) __hip_atomic_store(SW + n, cm * (1.0f / 127.0f), __ATOMIC_RELAXED, __HIP_MEMORY_SCOPE_AGENT);
    }
    asm volatile("s_waitcnt vmcnt(0)" ::: "memory");
    __syncthreads();
    if (threadIdx.x == 0) (void)__hip_atomic_fetch_add(ctl + CW_QCNT, 1u, __ATOMIC_RELAXED, __HIP_MEMORY_SCOPE_AGENT);
}

__global__ void __launch_bounds__(NWAVES * 64, 2) mk_fwd(Args args) {
    extern __shared__ __attribute__((aligned(16))) unsigned char lds_raw[];
    LAS unsigned char* lds = (LAS unsigned char*)lds_raw;
    volatile LAS unsigned* MISC = (volatile LAS unsigned*)(lds + MISC_OFF);
    const int tid = threadIdx.x, lane = tid & 63, wave = __builtin_amdgcn_readfirstlane(tid >> 6);
    const int G = gridDim.x;
    unsigned char* ws = args.ws;
    unsigned* ctl = (unsigned*)(ws + WS_CTL);
    if (tid < 64) MISC[tid] = 0u;
    __syncthreads();
    if (tid == 0) __hip_atomic_store(ctl + CW_XCC + blockIdx.x, xb_xcc_id() + 1u, __ATOMIC_RELAXED, __HIP_MEMORY_SCOPE_AGENT);
    XcdBarrier bar; bar.bar = ctl + CW_BAR; bar.x = 0; bar.st = nullptr;
    if (N_LAUNCHES == 1) bar = xcd_barrier_post(ctl + CW_BAR, MISC + 8);
#define GRID_BAR() do { if (N_LAUNCHES == 1) xcd_barrier(bar); } while (0)
    const int lo = args.ph_lo, hi = args.ph_hi;
#define IN(k) (lo <= (k) && (k) < hi)
    bf16* W1T = (bf16*)(ws + WS_W1T); bf16* W2T = (bf16*)(ws + WS_W2T); bf16* XB = (bf16*)(ws + WS_XB); bf16* Y = (bf16*)(ws + WS_Y);
    float* SSQ = (float*)(ws + WS_SSQ);

#define PHASE_P0() do { if (IN(0)) { PROF_START(25, lds, wave); p0_prologue(args, lds, blockIdx.x * NWAVES + wave, G * NWAVES, wave, lane); PROF_STOP(25, lds, wave); PROF_START(24, lds, wave); P0_PARTNERS(); if (N_LAUNCHES == 1) { if (quad) xcd_barrier(bar, false, MISC[17] != 0u); else xcd_barrier(bar); } PROF_STOP(24, lds, wave); p0_quantize_w1(args, blockIdx.x * NWAVES + wave, G * NWAVES, lane); } } while (0)
    int my_pm; { pg8::StaticOrder S; S.init(M, NIN, G, (int)blockIdx.x); pg8::Unit u0, u1; S.next(0, u0); my_pm = u0.pm; bool same = true; for (int i = 1; S.next(i, u1); ++i) same &= (u1.pm == u0.pm);
                 pg8::StaticOrder S2; S2.init(M, D, G, (int)blockIdx.x); S2.next(0, u1); same &= (u1.pm == u0.pm) && G == 256; if (!same) my_pm = -1; }
    const bool quad = (MK_QUAD != 0) && N_LAUNCHES == 1 && my_pm >= 0;
    unsigned* seamw = ctl + CW_CNT + (my_pm < 0 ? 0 : my_pm) * 16;
#define SEAM_DONE(s_) do { PROF_START(21, lds, wave); if (quad) seam_arrive(seamw + (s_) * 1024, MISC[17] != 0u); else GRID_BAR(); PROF_STOP(21, lds, wave); } while (0)
#define SEAM_WAIT(s_) do { PROF_START(20, lds, wave); if (quad) seam_wait(seamw + (s_) * 1024, 4u, ctl + CW_TMO, 0x600u + (s_)); PROF_STOP(20, lds, wave); } while (0)
#define PHASE_G1(l) do { if (IN(1 + 2 * (l))) { \
            if ((l) > 0) SEAM_WAIT(1); \
            if ((l) > 0) { if (tid < 64) { unsigned sp = 0; while ((unsigned)__builtin_amdgcn_readfirstlane(__hip_atomic_load(ctl + CW_QCNT, __ATOMIC_RELAXED, __HIP_MEMORY_SCOPE_AGENT)) < (unsigned)G && ++sp < (1u << 20)) __builtin_amdgcn_s_sleep(1); } __syncthreads(); }     \
            pg8::Gemm g{(l) ? (const bf16*)(ws + WS_XQ) : XB, (l) ? (const bf16*)(ws + WS_W1Q) : W1T, M, NIN, (l) ? D / 2 : D};     \
            pg8::StaticOrder S; S.init(M, NIN, G, (int)blockIdx.x); \
            pg8::EpiMixT<(l) == 1> E{Y, SSQ, args.in[3] + (size_t)(l) * 3 * 512, args.in[4] + (size_t)(l) * 512, args.in[6] + (size_t)(l) * 512, \
                          (float*)(ws + WS_HALO) + (size_t)(l) * 768 * pg8::HALO_TILE, ctl + CW_FLAG + (l) * 768 * 16, ctl + CW_TMO, (unsigned)((l) + 1), (const float*)(ws + WS_SA), (const float*)(ws + WS_SW), (unsigned long long*)(ws + WS_HGA) + (size_t)(l) * 8 * 64 * 128}; \
            pg8::gemm_phase<pg8::EpiMixT<(l) == 1>, pg8::StaticOrder, true, true, (l) == 1>(lds, g, S, E); \
            SEAM_DONE(2 * (l)); } } while (0)
#define PHASE_G2_0() do { if (IN(2)) { \
        SEAM_WAIT(0); \
        pg8::Gemm g{Y, W2T, M, D, D}; pg8::StaticOrder S; S.init(M, D, G, (int)blockIdx.x); \
        pg8::EpiRms<0> E{XB, nullptr, XB, SSQ, args.in[8], (unsigned long long*)(ws + WS_XSLOT), ctl + CW_TMO, 1u, (unsigned long long*)(ws + WS_XS2), (float*)(ws + WS_SA), (signed char*)(ws + WS_XQ)}; \
        pg8::gemm_phase<pg8::EpiRms<0>, pg8::StaticOrder, false, true>(lds, g, S, E); SEAM_DONE(1); } } while (0)
#define PHASE_G2_1(last) do { if (IN(4)) { \
        SEAM_WAIT(2); \
        pg8::Gemm g{Y, W2T + (size_t)D * D, M, D, D}; pg8::StaticOrder S; S.init(M, D, G, (int)blockIdx.x); \
        pg8::EpiRms<1> E{XB, args.out, nullptr, nullptr, args.in[8] + D, (unsigned long long*)(ws + WS_XSLOT) + (size_t)M * 4, ctl + CW_TMO, 2u, nullptr, nullptr, nullptr}; \
        pg8::gemm_phase<pg8::EpiRms<1>, pg8::StaticOrder, false, true>(lds, g, S, E); if (!(last)) GRID_BAR(); } } while (0)
#define P0_PARTNERS() do { if (quad && tid == 0) { \
        const unsigned c0 = (blockIdx.x & 7u) + 8u * ((blockIdx.x >> 3) & 7u); const unsigned mine = xb_xcc_id() + 1u; unsigned diff = 0u; \
        for (unsigned k = 0; k < 4; ++k) { unsigned v = 0u, sp = 0u; \
            while ((v = __hip_atomic_load(ctl + CW_XCC + c0 + 64u * k, __ATOMIC_RELAXED, __HIP_MEMORY_SCOPE_AGENT)) == 0u && ++sp < (1u << 16)) __builtin_amdgcn_s_sleep(1); \
            diff |= (v != mine) ? 1u : 0u; } \
        MISC[17] = diff; } \
    __syncthreads(); } while (0)
    PHASE_P0();
    PHASE_G1(0);
    PHASE_G2_0();
    PHASE_G1(1);
    PHASE_G2_1(true);
#undef PHASE_P0
#undef P0_PARTNERS
#undef SEAM_DONE
#undef SEAM_WAIT
#undef PHASE_G2_0
#undef PHASE_G2_1
    if (PROF_ID != 0 && blockIdx.x == PROF_BLOCK && tid == 0) {
        const unsigned long long t0 = __builtin_amdgcn_s_memrealtime();
#ifdef PROF_CLK
        const unsigned long long want = (unsigned long long)MISC[20] / 10u;
#else
        const unsigned long long want = (unsigned long long)MISC[20] * PROF_SCALE;
#endif

        while (__builtin_amdgcn_s_memrealtime() - t0 < want) __builtin_amdgcn_s_sleep(8);
    }
#undef PHASE_G1
#undef IN
#undef GRID_BAR
}

extern "C" void kernel_launch(void* const* d_in, const int* in_sizes, int n_in, void* d_out, int out_size, void* d_ws, size_t ws_size, hipStream_t stream) {
    static int grid = 0;
    if (grid == 0) {
        if (n_in != 9 || in_sizes[0] != M * D || out_size != M * D || ws_size < WS_END) { fprintf(stderr, "kernel_launch: unexpected shapes (n_in %d, in0 %d, out %d, ws %zu); nothing launched\n", n_in, n_in > 0 ? in_sizes[0] : -1, out_size, ws_size); grid = -1; return; }
        int dev = 0, cus = 0, per_cu = 0;
        if (hipGetDevice(&dev) != hipSuccess || hipDeviceGetAttribute(&cus, hipDeviceAttributeMultiprocessorCount, dev) != hipSuccess) { grid = -1; return; }
        if (hipFuncSetAttribute((const void*)mk_fwd, hipFuncAttributeMaxDynamicSharedMemorySize, LDS_BYTES) != hipSuccess) { fprintf(stderr, "kernel_launch: hipFuncSetAttribute failed\n"); grid = -1; return; }
        if (hipOccupancyMaxActiveBlocksPerMultiprocessor(&per_cu, (const void*)mk_fwd, NWAVES * 64, LDS_BYTES) != hipSuccess || per_cu < 1) fprintf(stderr, "kernel_launch: occupancy query reports %d blocks per CU\n", per_cu);
        (void)hipGetLastError();
        grid = cus;
        if (grid != 256) fprintf(stderr, "kernel_launch: %d CUs; the fused GEMM2 epilogue expects 256 workgroups\n", grid);
    }
    if (grid < 0) return;
    (void)hipMemsetAsync((char*)d_ws + WS_CTL, 0, CTL_ZERO_BYTES, stream);
    Args a{};
    for (int i = 0; i < 9; ++i) a.in[i] = (const float*)d_in[i];
    a.out = (float*)d_out; a.ws = (unsigned char*)d_ws;
    for (int li = 0; li < N_LAUNCHES; ++li) {
        a.ph_lo = (N_LAUNCHES == 1) ? 0 : li; a.ph_hi = (N_LAUNCHES == 1) ? N_PHASES : li + 1;
        hipLaunchKernelGGL(mk_fwd, dim3(grid), dim3(NWAVES * 64), LDS_BYTES, stream, a);
    }
}
```

```cpp
#include <hip/hip_runtime.h>
#include <cstdio>
#include <cstdint>
#ifndef MK_QUAD
#define MK_QUAD 1
#endif
namespace pg8 {
#define PG8_LAS __attribute__((address_space(3)))
typedef unsigned short bf16_t;
typedef short bf16x8 __attribute__((ext_vector_type(8)));
typedef float f32x4 __attribute__((ext_vector_type(4)));
typedef unsigned u32x4 __attribute__((ext_vector_type(4)));
constexpr int BM = 256, BK = 64, HALF = 128, HTB = HALF * BK * 2  , STAGE_BYTES = 8 * HTB, NXCD = 8, WGM = 8;

__host__ __device__ __forceinline__ int lds_byte(int r, int c) { const int st = (r >> 4) * 2 + (c >> 5), rr = r & 15, cc = c & 31, ob = rr * 64 + cc * 2; return st * 1024 + (ob ^ (((ob >> 9) & 1) << 5)); }
__host__ __device__ __forceinline__ void stage_rc(int b, int& R, int& C) { const int st = b / 1024, sb = b % 1024, swz = sb ^ (((sb >> 9) & 1) << 5); R = (st >> 1) * 16 + swz / 64; C = (st & 1) * 32 + (swz % 64) / 2; }
__host__ __device__ __forceinline__ int perm32(int rho) { const int n = rho >> 4, i = rho & 15; return 8 * (i >> 2) + 4 * n + (i & 3); }

struct Unit { int pm, pn; };
struct Gemm { const bf16_t* A; const bf16_t* Bt; int M, N, K; };

struct StaticOrder {
    int nM, nN, nwg, G, c;
    __host__ __device__ __forceinline__ void init(int M, int N, int G_, int c_) { nM = M / BM; nN = N / BM; nwg = nM * nN; G = G_; c = c_; }
    __host__ __device__ __forceinline__ bool next(int i, Unit& u) const {
        const long L = (long)i * G + c; if (L >= nwg) return false;
        int wgid = (int)L; { const int q = nwg / NXCD, r = nwg % NXCD, xcd = wgid % NXCD, off = wgid / NXCD; wgid = (xcd < r ? xcd * (q + 1) : r * (q + 1) + (xcd - r) * q) + off; }
        const int nig = WGM * nN, gid = wgid / nig, fm = gid * WGM, gsz = (nM - fm) < WGM ? (nM - fm) : WGM;
        u.pm = fm + ((wgid % nig) % gsz); u.pn = (wgid % nig) / gsz; return true;
    }
    __device__ __forceinline__ void a_ready(const Unit&) const {}
    __device__ __forceinline__ void done(const Unit&) const {}
};


typedef unsigned u32x2 __attribute__((ext_vector_type(2)));
typedef int i32x4 __attribute__((ext_vector_type(4)));
__device__ __forceinline__ unsigned cvt_pk_bf16(float lo, float hi) { unsigned r; asm volatile("v_cvt_pk_bf16_f32 %0, %1, %2" : "=v"(r) : "v"(lo), "v"(hi)); return r; }
__device__ __forceinline__ float silu_f(float z) { return z * __builtin_amdgcn_rcpf(1.0f + __expf(-z)); }
__device__ __forceinline__ f32x4 mul_silu4(const f32x4& x, const f32x4& z) {
    const f32x4 t = z * (-1.44269504089f);
    f32x4 e; e[0] = __builtin_amdgcn_exp2f(t[0]); e[1] = __builtin_amdgcn_exp2f(t[1]); e[2] = __builtin_amdgcn_exp2f(t[2]); e[3] = __builtin_amdgcn_exp2f(t[3]);
    const f32x4 d = e + 1.0f;
    f32x4 r; r[0] = __builtin_amdgcn_rcpf(d[0]); r[1] = __builtin_amdgcn_rcpf(d[1]); r[2] = __builtin_amdgcn_rcpf(d[2]); r[3] = __builtin_amdgcn_rcpf(d[3]);
    return (x * z) * r;
}
template <int K> __device__ __forceinline__ float shl_prev(float cur, float prev) {
    const int t = __builtin_amdgcn_update_dpp(0, __float_as_int(prev), 0x120 + K, 0xf, 0xf, false);
    return __int_as_float(__builtin_amdgcn_update_dpp(t, __float_as_int(cur), 0x110 + K, 0xf, 0xf, false));
}
template <int K> __device__ __forceinline__ float shl_zero(float cur) { return __int_as_float(__builtin_amdgcn_update_dpp(0, __float_as_int(cur), 0x110 + K, 0xf, 0xf, true)); }

constexpr int HBS = 132;
constexpr int HB_BYTES = 3 * 16 * HBS * 4;
constexpr int HALO_TILE = 16 * 128;
constexpr int EPI_HB_OFF = STAGE_BYTES, EPI_MISC_OFF = EPI_HB_OFF + 25600, EPI_INV_OFF = EPI_MISC_OFF + 256, EPI_LDS_END = EPI_INV_OFF + 1024;
static_assert(HB_BYTES <= 25600, "halo images");

#ifndef PROF_ID
#define PROF_ID 0
#endif
#ifndef PROF_BLOCK
#define PROF_BLOCK 9
#endif
#ifndef PROF_WAVE
#define PROF_WAVE 0
#endif
#define PROF_SCALE 20u
#ifdef PROF_CLK
#define PROF_NOW() ((unsigned)__builtin_amdgcn_s_memtime())
#else
#define PROF_NOW() ((unsigned)__builtin_amdgcn_s_memrealtime())
#endif
#define PROF_START(n, lds_, wid_) do { if (PROF_ID == (n) && blockIdx.x == PROF_BLOCK && (wid_) == PROF_WAVE) { const unsigned t_ = PROF_NOW(); \
        if ((threadIdx.x & 63) == 0) ((volatile PG8_LAS unsigned*)((lds_) + pg8::EPI_MISC_OFF))[22] = t_; } } while (0)
#define PROF_STOP(n, lds_, wid_) do { if (PROF_ID == (n) && blockIdx.x == PROF_BLOCK && (wid_) == PROF_WAVE) { const unsigned t_ = PROF_NOW(); \
        if ((threadIdx.x & 63) == 0) { volatile PG8_LAS unsigned* m_ = (volatile PG8_LAS unsigned*)((lds_) + pg8::EPI_MISC_OFF); m_[20] = m_[20] + (t_ - m_[22]); } } } while (0)

__device__ __forceinline__ u32x2 mixA_block(const f32x4& gate, const f32x4& chv, const f32x4& prev, const f32x4& w0, const f32x4& w1, const f32x4& w2, const f32x4& cb) {
    f32x4 c1, c2;
#pragma unroll
    for (int j = 0; j < 4; ++j) { c1[j] = shl_prev<1>(chv[j], prev[j]); c2[j] = shl_prev<2>(chv[j], prev[j]); }
    const f32x4 o = gate * (w0 * c2 + w1 * c1 + w2 * chv + cb);
    u32x2 w; w.x = cvt_pk_bf16(o[0], o[1]); w.y = cvt_pk_bf16(o[2], o[3]); return w;
}
__device__ __forceinline__ u32x4 mixB_block(const f32x4 (&cu)[2], const f32x4 (&pu)[2], const f32x4 (&sg)[2], float rc, int w) {
    float o[8];
#pragma unroll
    for (int e = 0; e < 8; ++e) {
        const float uv = cu[e >> 2][e & 3], up = pu[e >> 2][e & 3];
        float s = uv + shl_prev<1>(uv, up);
        if (w >= 4) { float sp = up + shl_zero<1>(up); s += shl_prev<2>(s, sp);
            if (w >= 8) { sp += shl_zero<2>(sp); s += shl_prev<4>(s, sp);
                if (w >= 16) { sp += shl_zero<4>(sp); s += shl_prev<8>(s, sp); } } }
        o[e] = (s * rc - uv) * sg[e >> 2][e & 3];
    }
    u32x4 wv; wv.x = cvt_pk_bf16(o[0], o[1]); wv.y = cvt_pk_bf16(o[2], o[3]); wv.z = cvt_pk_bf16(o[4], o[5]); wv.w = cvt_pk_bf16(o[6], o[7]); return wv;
}
template <int K> __device__ __forceinline__ float shl_zero_fwd(float cur) { return __int_as_float(__builtin_amdgcn_update_dpp(0, __float_as_int(cur), 0x100 + K, 0xf, 0xf, true)); }
template <int K> __device__ __forceinline__ float row_ror(float cur) { return __int_as_float(__builtin_amdgcn_update_dpp(0, __float_as_int(cur), 0x120 + K, 0xf, 0xf, false)); }
template <int W> __device__ __forceinline__ void lead_sums(const f32x4 (&p)[2], f32x4 (&q)[2]) {
#pragma unroll
    for (int e = 0; e < 8; ++e) { float t = p[e >> 2][e & 3]; t += shl_zero_fwd<1>(t); if (W >= 4) t += shl_zero_fwd<2>(t); if (W >= 8) t += shl_zero_fwd<4>(t); if (W >= 16) t += shl_zero_fwd<8>(t); q[e >> 2][e & 3] = t; }
}
template <int W> __device__ __forceinline__ u32x4 mixB_blockT(const f32x4 (&cu)[2], const f32x4 (&pq)[2], const f32x4 (&sg)[2], float rc, float maskf) {
    float o[8];
#pragma unroll
    for (int e = 0; e < 8; ++e) {
        const float uv = cu[e >> 2][e & 3];
        float s = uv + shl_zero<1>(uv); if (W >= 4) s += shl_zero<2>(s); if (W >= 8) s += shl_zero<4>(s); if (W >= 16) s += shl_zero<8>(s);
        s = fmaf(row_ror<W - 1>(pq[e >> 2][e & 3]), maskf, s);
        o[e] = (s * rc - uv) * sg[e >> 2][e & 3];
    }
    u32x4 wv; wv.x = cvt_pk_bf16(o[0], o[1]); wv.y = cvt_pk_bf16(o[2], o[3]); wv.z = cvt_pk_bf16(o[4], o[5]); wv.w = cvt_pk_bf16(o[6], o[7]); return wv;
}
__device__ __forceinline__ void st_sc1_f32x4(float* p, const f32x4& v) {
    __hip_atomic_store((unsigned long long*)p, ((unsigned long long)__float_as_uint(v[1]) << 32) | __float_as_uint(v[0]), __ATOMIC_RELAXED, __HIP_MEMORY_SCOPE_AGENT);
    __hip_atomic_store((unsigned long long*)p + 1, ((unsigned long long)__float_as_uint(v[3]) << 32) | __float_as_uint(v[2]), __ATOMIC_RELAXED, __HIP_MEMORY_SCOPE_AGENT);
}
__device__ __forceinline__ void st_pay_u32x2(void* p, const u32x2& v) {
    *(u32x2*)p = v;
}
__device__ __forceinline__ void st_pay_u32x4(void* p, const u32x4& v) {
    *(u32x4*)p = v;
}
__device__ __forceinline__ void st_pay_f32(float* p, float v) {
    *p = v;
}
__device__ __forceinline__ f32x4 ld_sc1_f32x4(const float* p) {
    const unsigned long long a = __hip_atomic_load((unsigned long long*)p, __ATOMIC_RELAXED, __HIP_MEMORY_SCOPE_AGENT), b = __hip_atomic_load((unsigned long long*)p + 1, __ATOMIC_RELAXED, __HIP_MEMORY_SCOPE_AGENT);
    return (f32x4){__uint_as_float((unsigned)a), __uint_as_float((unsigned)(a >> 32)), __uint_as_float((unsigned)b), __uint_as_float((unsigned)(b >> 32))};
}

template <bool I8> struct EpiMixT {
    static constexpr bool PERM = false, AFTER_DRAIN = false;
    bf16_t* Y; const float* ssqp; const float* convw; const float* convb; const float* pscale;
    float* halo; unsigned* flags; unsigned* tmo; unsigned epoch;
    const float* sa; const float* sw;
    unsigned long long* hga;
    __device__ __forceinline__ void sweepA(const unsigned long long* g, bool active, f32x4& v, const Unit& u, int lane) const {
        for (unsigned sp = 0;;) { bool ok = true;
            if (active) {
#pragma unroll
                for (int k = 0; k < 4; ++k) { const unsigned long long x = __hip_atomic_load((unsigned long long*)g + k, __ATOMIC_RELAXED, __HIP_MEMORY_SCOPE_AGENT); v[k] = __uint_as_float((unsigned)x); ok &= ((unsigned)(x >> 32) == epoch); } }
            if (__all(ok)) return;
            __builtin_amdgcn_s_sleep(2);
            if (++sp > (1u << 20)) { if (lane == 0) __hip_atomic_store(tmo, 0x500u | (unsigned)u.pn, __ATOMIC_RELAXED, __HIP_MEMORY_SCOPE_AGENT); return; } }
    }
    __device__ __forceinline__ void wait_flag(const Unit& u, int lane) const {
        unsigned sp = 0; unsigned* fl = flags + ((u.pm - 1) * 12 + u.pn) * 16; const unsigned want = 4u;
        while ((unsigned)__builtin_amdgcn_readfirstlane(__hip_atomic_load(fl, __ATOMIC_RELAXED, __HIP_MEMORY_SCOPE_AGENT)) < want) { __builtin_amdgcn_s_sleep(1);
            if (++sp > (1u << 20)) { if (lane == 0) __hip_atomic_store(tmo, 0x500u | (unsigned)u.pn, __ATOMIC_RELAXED, __HIP_MEMORY_SCOPE_AGENT); break; } }
    }
    __device__ __forceinline__ u32x4 b_block(int g, const f32x4 (&cu)[2], const f32x4 (&pu)[2], const f32x4 (&sg)[2], float rc, int fr) const {
        f32x4 q[2]; u32x4 r;
        if (g == 0) { lead_sums<2>(pu, q); r = mixB_blockT<2>(cu, q, sg, rc, fr < 1 ? 1.0f : 0.0f); }
        else if (g == 1) { lead_sums<4>(pu, q); r = mixB_blockT<4>(cu, q, sg, rc, fr < 3 ? 1.0f : 0.0f); }
        else if (g == 2) { lead_sums<8>(pu, q); r = mixB_blockT<8>(cu, q, sg, rc, fr < 7 ? 1.0f : 0.0f); }
        else { lead_sums<16>(pu, q); r = mixB_blockT<16>(cu, q, sg, rc, fr < 15 ? 1.0f : 0.0f); }
        return r;
    }
    __device__ __forceinline__ void operator()(f32x4 (&acc)[2][2][4][2], const Unit& u, int wr, int wc, int fr, int fq, PG8_LAS unsigned char* lds, int wid, int lane) const {
        asm volatile("" : "+v"(fr), "+v"(fq), "+v"(lane));
        f32x4 swv[2][2];
        if constexpr (I8) { const float* swp = sw + u.pn * BM + 32 * wc + 4 * fq;
#pragma unroll
            for (int bj = 0; bj < 2; ++bj)
#pragma unroll
                for (int n = 0; n < 2; ++n) swv[bj][n] = *(const f32x4*)(swp + HALF * bj + 16 * n); }
        PROF_START(2, lds, wid);
        PG8_LAS float* HB = (PG8_LAS float*)(lds + EPI_HB_OFF);
        PG8_LAS float* INV = (PG8_LAS float*)(lds + EPI_INV_OFF);
        volatile PG8_LAS unsigned* KEY = (volatile PG8_LAS unsigned*)(lds + EPI_MISC_OFF + 64);
        const unsigned key = (epoch << 16) | (unsigned)u.pm;
        if (KEY[0] != key) {
            int t = threadIdx.x; asm volatile("" : "+v"(t));
            if (t < 256) { const f32x4 p = *(const f32x4*)(ssqp + (size_t)(u.pm * BM + t) * 4); INV[t] = rsqrtf(((p[0] + p[1]) + (p[2] + p[3])) * (1.0f / 1024.0f) + 1e-6f) * (I8 ? sa[(size_t)u.pm * BM + t] : 1.0f); }
            asm volatile("s_waitcnt lgkmcnt(0)" ::: "memory"); __builtin_amdgcn_s_barrier(); asm volatile("" ::: "memory");
            if (t == 0) KEY[0] = key;
        }
        const int rl = wr * 64 + fr, row0 = u.pm * BM + rl;
        const bool need = (u.pm & 31) != 0;
        float* halo_out = halo + (size_t)(u.pn * 64 + u.pm) * HALO_TILE;
        const float* halo_in = halo_out - HALO_TILE;
        unsigned* myflag = flags + (u.pm * 12 + u.pn) * 16;
        float inv[2][4];
#pragma unroll
        for (int ai = 0; ai < 2; ++ai)
#pragma unroll
            for (int m = 0; m < 4; ++m) inv[ai][m] = INV[rl + ai * HALF + m * 16];
        const f32x4 zero = {0.f, 0.f, 0.f, 0.f};
        if constexpr (I8) {
#pragma unroll
            for (int bj = 0; bj < 2; ++bj)
#pragma unroll
                for (int n = 0; n < 2; ++n)
#pragma unroll
                    for (int ai = 0; ai < 2; ++ai)
#pragma unroll
                        for (int m = 0; m < 4; ++m) acc[ai][bj][m][n] = __builtin_convertvector(__builtin_bit_cast(i32x4, acc[ai][bj][m][n]), f32x4) * swv[bj][n];
        }
        if (u.pn < 8) {
            const int chl = 16 * wc + 4 * fq, chg = 64 * u.pn + chl;
            const f32x4 w0 = *(const f32x4*)(convw + chg), w1 = *(const f32x4*)(convw + 512 + chg), w2 = *(const f32x4*)(convw + 1024 + chg), cb = *(const f32x4*)(convb + chg);
            unsigned long long* ga = hga + (size_t)(u.pn * 64 + u.pm) * 128 + (fr >= 14 ? (fr - 14) * 64 + chl : 0);
            if (wr == 1 && fr >= 14) { const float s = inv[1][3]; const f32x4 t = (acc[1][0][3][1] * s) * (acc[1][1][3][0] * s);
#pragma unroll
                for (int j = 0; j < 4; ++j) __hip_atomic_store(ga + j, ((unsigned long long)epoch << 32) | __float_as_uint(t[j]), __ATOMIC_RELAXED, __HIP_MEMORY_SCOPE_AGENT); }
#pragma unroll
            for (int ai = 0; ai < 2; ++ai)
#pragma unroll
                for (int m = 0; m < 4; ++m) { const float s = inv[ai][m]; const f32x4 b = acc[ai][0][m][0] * s, c = acc[ai][0][m][1] * s, h = acc[ai][1][m][0] * s, z = acc[ai][1][m][1] * s; f32x4 g;
#pragma unroll
                    for (int j = 0; j < 4; ++j) g[j] = 0.f;
                    acc[ai][0][m][0] = mul_silu4(b, z); acc[ai][0][m][1] = c * h; }
            PROF_STOP(2, lds, wid); PROF_START(3, lds, wid);
            if (fr >= 14) {
                *(PG8_LAS f32x4*)(HB + (wr * 16 + fr) * HBS + chl) = acc[0][0][3][1];
                if (wr == 0) *(PG8_LAS f32x4*)(HB + (32 + fr) * HBS + chl) = acc[1][0][3][1];
            }
            asm volatile("s_waitcnt lgkmcnt(0)" ::: "memory"); __builtin_amdgcn_s_barrier(); asm volatile("" ::: "memory");
            PROF_STOP(3, lds, wid); PROF_START(4, lds, wid);
            u32x2 o[2][4];
            { const f32x4 pv = (fr >= 14) ? *(const PG8_LAS f32x4*)(HB + ((1 + wr) * 16 + fr) * HBS + chl) : zero;
              o[1][0] = mixA_block(acc[1][0][0][0], acc[1][0][0][1], pv, w0, w1, w2, cb); }
#pragma unroll
            for (int m = 1; m < 4; ++m) o[1][m] = mixA_block(acc[1][0][m][0], acc[1][0][m][1], acc[1][0][m - 1][1], w0, w1, w2, cb);
            PROF_STOP(4, lds, wid); PROF_START(5, lds, wid);
            f32x4 pvg = zero;
            if (wr == 1) { if (fr >= 14) pvg = *(const PG8_LAS f32x4*)(HB + fr * HBS + chl); }
            else if (need) sweepA(ga - 128, fr >= 14, pvg, u, lane);
            PROF_STOP(5, lds, wid); PROF_START(6, lds, wid);
#pragma unroll
            for (int m = 1; m < 4; ++m) o[0][m] = mixA_block(acc[0][0][m][0], acc[0][0][m][1], acc[0][0][m - 1][1], w0, w1, w2, cb);
            o[0][0] = mixA_block(acc[0][0][0][0], acc[0][0][0][1], pvg, w0, w1, w2, cb);
            PROF_STOP(6, lds, wid); PROF_START(7, lds, wid);
            bf16_t* yp = Y + (size_t)row0 * 1024 + chg;
#pragma unroll
            for (int ai = 0; ai < 2; ++ai)
#pragma unroll
                for (int m = 0; m < 4; ++m) st_pay_u32x2(yp + (size_t)(ai * HALF + 16 * m) * 1024, o[ai][m]);
            PROF_STOP(7, lds, wid);
        } else {
            const int g = u.pn - 8, dl = 32 * wc + 8 * fq;
            const f32x4 sc0 = *(const f32x4*)(pscale + 128 * g + dl), sc1 = *(const f32x4*)(pscale + 128 * g + dl + 4);
            if (wr == 1) { const float s = inv[1][3]; st_sc1_f32x4(halo_out + fr * 128 + dl, acc[1][0][3][0] * s); st_sc1_f32x4(halo_out + fr * 128 + dl + 4, acc[1][0][3][1] * s); }
#pragma unroll
            for (int ai = 0; ai < 2; ++ai)
#pragma unroll
                for (int m = 0; m < 4; ++m) { const float s = inv[ai][m];
#pragma unroll
                    for (int n = 0; n < 2; ++n) { const f32x4 uu = acc[ai][0][m][n] * s, z = acc[ai][1][m][n] * s; f32x4 sg;
#pragma unroll
                        for (int j = 0; j < 4; ++j) sg[j] = 0.f;
                        acc[ai][0][m][n] = uu; acc[ai][1][m][n] = mul_silu4(n ? sc1 : sc0, z); } }
            PROF_STOP(2, lds, wid); PROF_START(3, lds, wid);
#pragma unroll
            for (int n = 0; n < 2; ++n) {
                *(PG8_LAS f32x4*)(HB + (wr * 16 + fr) * HBS + dl + 4 * n) = acc[0][0][3][n];
                if (wr == 0) *(PG8_LAS f32x4*)(HB + (32 + fr) * HBS + dl + 4 * n) = acc[1][0][3][n];
            }
            asm volatile("s_waitcnt lgkmcnt(0)" ::: "memory"); __builtin_amdgcn_s_barrier(); asm volatile("" ::: "memory");
            if (wr == 1) { asm volatile("s_waitcnt vmcnt(0)" ::: "memory"); if (lane == 0) __hip_atomic_fetch_add(myflag, 1u, __ATOMIC_RELAXED, __HIP_MEMORY_SCOPE_AGENT); }
            const int tpos0 = (u.pm * BM + rl) & 8191;
            const float fw = (float)(2 << g);
#define MIXB_RC(ai, m) (need ? (1.0f / fw) : 1.0f / fminf((float)(tpos0 + (ai) * HALF + (m) * 16 + 1), fw))
            PROF_STOP(3, lds, wid); PROF_START(4, lds, wid);
            u32x4 o[2][4];
            { f32x4 pv[2]; pv[0] = *(const PG8_LAS f32x4*)(HB + ((1 + wr) * 16 + fr) * HBS + dl); pv[1] = *(const PG8_LAS f32x4*)(HB + ((1 + wr) * 16 + fr) * HBS + dl + 4);
              o[1][0] = b_block(g, acc[1][0][0], pv, acc[1][1][0], MIXB_RC(1, 0), fr); }
#pragma unroll
            for (int m = 1; m < 4; ++m) o[1][m] = b_block(g, acc[1][0][m], acc[1][0][m - 1], acc[1][1][m], MIXB_RC(1, m), fr);
            PROF_STOP(4, lds, wid); PROF_START(5, lds, wid);
            f32x4 pvg[2]; pvg[0] = zero; pvg[1] = zero;
            if (wr == 1) { pvg[0] = *(const PG8_LAS f32x4*)(HB + fr * HBS + dl); pvg[1] = *(const PG8_LAS f32x4*)(HB + fr * HBS + dl + 4); }
            else if (need) { wait_flag(u, lane); pvg[0] = ld_sc1_f32x4(halo_in + fr * 128 + dl); pvg[1] = ld_sc1_f32x4(halo_in + fr * 128 + dl + 4); }
            PROF_STOP(5, lds, wid); PROF_START(6, lds, wid);
#pragma unroll
            for (int m = 1; m < 4; ++m) o[0][m] = b_block(g, acc[0][0][m], acc[0][0][m - 1], acc[0][1][m], MIXB_RC(0, m), fr);
            o[0][0] = b_block(g, acc[0][0][0], pvg, acc[0][1][0], MIXB_RC(0, 0), fr);
#undef MIXB_RC
            PROF_STOP(6, lds, wid); PROF_START(7, lds, wid);
            bf16_t* yp = Y + (size_t)row0 * 1024 + 512 + 128 * g + dl;
#pragma unroll
            for (int ai = 0; ai < 2; ++ai)
#pragma unroll
                for (int m = 0; m < 4; ++m) st_pay_u32x4(yp + (size_t)(ai * HALF + 16 * m) * 1024, o[ai][m]);
            PROF_STOP(7, lds, wid);
        }
    }
};

template <int MODE> struct EpiRms {
    static constexpr bool PERM = true, AFTER_DRAIN = true;
    const bf16_t* base_b; float* out_f; bf16_t* out_b; float* ssq_out; const float* gpost;
    unsigned long long* xslot; unsigned* tmo; unsigned tag;
    unsigned long long* xslot2; float* sa_out; signed char* xq;
    __device__ __forceinline__ void fused(f32x4 (&acc)[2][2][4][2], const Unit& u, int wr, int wc, int fr, int fq, PG8_LAS unsigned char* lds, int wid, int lane) const {
        PG8_LAS float* P = (PG8_LAS float*)lds;
        PG8_LAS float* S = (PG8_LAS float*)(lds + 4096);
        PG8_LAS float* PM = (PG8_LAS float*)(lds + 8192);
        PG8_LAS float* S2 = (PG8_LAS float*)(lds + 12288);
        PROF_START(30, lds, wid);
#pragma unroll
        for (int ai = 0; ai < 2; ++ai)
#pragma unroll
            for (int m = 0; m < 4; ++m) { float s = 0.f;
#pragma unroll
                for (int bj = 0; bj < 2; ++bj)
#pragma unroll
                    for (int n = 0; n < 2; ++n) { const f32x4 x = acc[ai][bj][m][n]; s += (x[0] * x[0] + x[1] * x[1]) + (x[2] * x[2] + x[3] * x[3]); }
                s += __shfl_xor(s, 16); s += __shfl_xor(s, 32);
                if (fq == 0) P[(ai * HALF + wr * 64 + m * 16 + fr) * 4 + wc] = s; }
        asm volatile("s_waitcnt lgkmcnt(0)" ::: "memory"); __builtin_amdgcn_s_barrier(); asm volatile("" ::: "memory");
        PROF_STOP(30, lds, wid); PROF_START(31, lds, wid);
        const int row = wid * 32 + (lane & 31);
        unsigned long long* slot = xslot + (size_t)(u.pm * BM + row) * 4;
        if (lane < 32) { const f32x4 p = *(const PG8_LAS f32x4*)(P + row * 4); const float t = (p[0] + p[1]) + (p[2] + p[3]);
            __hip_atomic_store(slot + u.pn, ((unsigned long long)tag << 32) | __float_as_uint(t), __ATOMIC_RELAXED, __HIP_MEMORY_SCOPE_AGENT); }
        const int col0 = u.pn * BM + wc * 32 + 8 * fq;
        const size_t off0 = (size_t)(u.pm * BM + wr * 64 + fr) * 1024 + col0;
        u32x4 rb[2][4][2];
#define RMS_LOAD_RES(ai) do { _Pragma("unroll") for (int m = 0; m < 4; ++m) _Pragma("unroll") for (int bj = 0; bj < 2; ++bj) \
            rb[ai][m][bj] = *(const u32x4*)(base_b + off0 + (size_t)((ai) * HALF + m * 16) * 1024 + bj * HALF); } while (0)
        RMS_LOAD_RES(0);
        f32x4 gv[2][2];
#pragma unroll
        for (int bj = 0; bj < 2; ++bj)
#pragma unroll
            for (int n = 0; n < 2; ++n) gv[bj][n] = *(const f32x4*)(gpost + col0 + bj * HALF + 4 * n);
        PROF_STOP(31, lds, wid); PROF_START(32, lds, wid);
        if (lane < 32) { float t = 0.f; unsigned sp = 0;
            for (;;) { bool ok = true; t = 0.f;
#pragma unroll
                for (int k = 0; k < 4; ++k) { const unsigned long long g = __hip_atomic_load(slot + k, __ATOMIC_RELAXED, __HIP_MEMORY_SCOPE_AGENT); ok &= ((unsigned)(g >> 32) == tag); t += __uint_as_float((unsigned)g); }
                if (ok) break;
                __builtin_amdgcn_s_sleep(1);
                if (++sp > (1u << 20)) { __hip_atomic_store(tmo, 0x700u | (unsigned)u.pm, __ATOMIC_RELAXED, __HIP_MEMORY_SCOPE_AGENT); break; } }
            S[row] = rsqrtf(t * (1.0f / 1024.0f) + 1e-6f); }
        asm volatile("s_waitcnt lgkmcnt(0)" ::: "memory"); __builtin_amdgcn_s_barrier(); asm volatile("" ::: "memory");
        PROF_STOP(32, lds, wid); PROF_START(33, lds, wid);
        u32x4 keep[2][4][2];
        RMS_LOAD_RES(1);
#undef RMS_LOAD_RES
        asm volatile("" ::: "memory");
#pragma unroll
        for (int ai = 0; ai < 2; ++ai)
#pragma unroll
            for (int m = 0; m < 4; ++m) { const int r = ai * HALF + wr * 64 + m * 16 + fr; const float iv = S[r]; const size_t off = off0 + (size_t)(ai * HALF + m * 16) * 1024; float q = 0.f, mx = 0.f;
#pragma unroll
                for (int bj = 0; bj < 2; ++bj) { const u32x4 bb = rb[ai][m][bj];
                    f32x4 b0, b1; b0[0] = __uint_as_float(bb.x << 16); b0[1] = __uint_as_float(bb.x & 0xffff0000u); b0[2] = __uint_as_float(bb.y << 16); b0[3] = __uint_as_float(bb.y & 0xffff0000u);
                    b1[0] = __uint_as_float(bb.z << 16); b1[1] = __uint_as_float(bb.z & 0xffff0000u); b1[2] = __uint_as_float(bb.w << 16); b1[3] = __uint_as_float(bb.w & 0xffff0000u);
                    const f32x4 o0 = b0 + acc[ai][bj][m][0] * iv * gv[bj][0], o1 = b1 + acc[ai][bj][m][1] * iv * gv[bj][1];
                    if (MODE == 0) { q += ((o0[0] * o0[0] + o0[1] * o0[1]) + (o0[2] * o0[2] + o0[3] * o0[3])) + ((o1[0] * o1[0] + o1[1] * o1[1]) + (o1[2] * o1[2] + o1[3] * o1[3]));
                        mx = fmaxf(mx, fmaxf(fmaxf(fmaxf(fabsf(o0[0]), fabsf(o0[1])), fmaxf(fabsf(o0[2]), fabsf(o0[3]))), fmaxf(fmaxf(fabsf(o1[0]), fabsf(o1[1])), fmaxf(fabsf(o1[2]), fabsf(o1[3])))));
                        u32x4 wv; wv.x = cvt_pk_bf16(o0[0], o0[1]); wv.y = cvt_pk_bf16(o0[2], o0[3]); wv.z = cvt_pk_bf16(o1[0], o1[1]); wv.w = cvt_pk_bf16(o1[2], o1[3]); st_pay_u32x4(out_b + off + bj * HALF, wv); keep[ai][m][bj] = wv; }
                    else { __builtin_nontemporal_store(o0, (f32x4*)(out_f + off + bj * HALF)); __builtin_nontemporal_store(o1, (f32x4*)(out_f + off + bj * HALF + 4)); } }
                if (MODE == 0) { q += __shfl_xor(q, 16); q += __shfl_xor(q, 32); mx = fmaxf(mx, __shfl_xor(mx, 16)); mx = fmaxf(mx, __shfl_xor(mx, 32)); if (fq == 0) { P[r * 4 + wc] = q; PM[r * 4 + wc] = mx; } } }
        PROF_STOP(33, lds, wid); PROF_START(34, lds, wid);
        if (MODE == 0) {
            asm volatile("s_waitcnt lgkmcnt(0)" ::: "memory"); __builtin_amdgcn_s_barrier(); asm volatile("" ::: "memory");
            if (lane < 32) { const f32x4 p = *(const PG8_LAS f32x4*)(P + row * 4); st_pay_f32(ssq_out + (size_t)(u.pm * BM + row) * 4 + u.pn, (p[0] + p[1]) + (p[2] + p[3])); }
            unsigned long long* slot2 = xslot2 + (size_t)(u.pm * BM + row) * 4;
            if (lane < 32) { const f32x4 pm4 = *(const PG8_LAS f32x4*)(PM + row * 4);
                __hip_atomic_store(slot2 + u.pn, ((unsigned long long)tag << 32) | __float_as_uint(fmaxf(fmaxf(pm4[0], pm4[1]), fmaxf(pm4[2], pm4[3]))), __ATOMIC_RELAXED, __HIP_MEMORY_SCOPE_AGENT);
                float rmx = 0.f; unsigned sp = 0;
                for (;;) { bool ok = true; rmx = 0.f;
#pragma unroll
                    for (int k = 0; k < 4; ++k) { const unsigned long long g = __hip_atomic_load(slot2 + k, __ATOMIC_RELAXED, __HIP_MEMORY_SCOPE_AGENT); ok &= ((unsigned)(g >> 32) == tag); rmx = fmaxf(rmx, __uint_as_float((unsigned)g)); }
                    if (ok) break;
                    __builtin_amdgcn_s_sleep(1);
                    if (++sp > (1u << 20)) { __hip_atomic_store(tmo, 0x780u | (unsigned)u.pm, __ATOMIC_RELAXED, __HIP_MEMORY_SCOPE_AGENT); break; } }
                rmx = fmaxf(rmx, 1e-30f); S2[row] = 127.0f / rmx;
                if (u.pn == 0) st_pay_f32(sa_out + (size_t)u.pm * BM + row, rmx * (1.0f / 127.0f)); }
            asm volatile("s_waitcnt lgkmcnt(0)" ::: "memory"); __builtin_amdgcn_s_barrier(); asm volatile("" ::: "memory");
#pragma unroll
            for (int ai = 0; ai < 2; ++ai)
#pragma unroll
                for (int m = 0; m < 4; ++m) { const int r = ai * HALF + wr * 64 + m * 16 + fr; const float qs = S2[r]; const size_t off = off0 + (size_t)(ai * HALF + m * 16) * 1024;
#pragma unroll
                    for (int bj = 0; bj < 2; ++bj) { const u32x4 bb = keep[ai][m][bj]; const unsigned w4[4] = {bb.x, bb.y, bb.z, bb.w}; unsigned f[8];
#pragma unroll
                        for (int i = 0; i < 4; ++i) { f[2 * i] = __float_as_uint(fmaf(__uint_as_float(w4[i] << 16), qs, 12582912.0f)); f[2 * i + 1] = __float_as_uint(fmaf(__uint_as_float(w4[i] & 0xffff0000u), qs, 12582912.0f)); }
                        u32x2 o; o.x = __builtin_amdgcn_perm(__builtin_amdgcn_perm(f[3], f[2], 0x0c0c0400u), __builtin_amdgcn_perm(f[1], f[0], 0x0c0c0400u), 0x05040100u);
                        o.y = __builtin_amdgcn_perm(__builtin_amdgcn_perm(f[7], f[6], 0x0c0c0400u), __builtin_amdgcn_perm(f[5], f[4], 0x0c0c0400u), 0x05040100u);
                        st_pay_u32x2(xq + off + bj * HALF, o); } }
        }
    }
};

template <class Epi, class Sched, bool ALIGN_EPI = false, bool SP2 = false, bool I8 = false>
__device__ __forceinline__ void gemm_phase(PG8_LAS unsigned char* lds, const Gemm g, const Sched& S, const Epi& E) {
    const int tid = threadIdx.x, wid = __builtin_amdgcn_readfirstlane(tid >> 6), lane = tid & 63, wr = wid >> 2, wc = wid & 3, fr = lane & 15, fq = lane >> 4;
    const int K = g.K, nt = K / BK;
    unsigned voffA[2], voffB[2];
#pragma unroll
    for (int i = 0; i < 2; ++i) { int R, C; stage_rc(tid * 16 + i * 8192, R, C); const int Rb = Epi::PERM ? ((R & ~31) + perm32(R & 31)) : R;
        voffA[i] = (unsigned)(R * K + C) * 2u; voffB[i] = (unsigned)(Rb * K + C) * 2u; }
    const size_t kstep = (size_t)(BK * 2);
    const size_t hstep = (size_t)HALF * K * 2;
    const size_t tstep = 2 * hstep;
    const unsigned ldsw = (unsigned)wid * 1024u;
    const int aoff = lds_byte(wr * 64 + fr, fq * 8), boff = lds_byte(wc * 32 + fr, fq * 8);
#define PG8_SA(b, h) (((b) * 2 + (h)) * HTB)
#define PG8_SB(b, h) ((4 + (b) * 2 + (h)) * HTB)
#define PG8_STAGE(bufoff, gbase, voff) do { _Pragma("unroll") for (int _i = 0; _i < 2; ++_i) \
        __builtin_amdgcn_global_load_lds((const unsigned*)((const char*)(gbase) + (voff)[_i]), (PG8_LAS unsigned*)(lds + (bufoff) + ldsw + _i * 8192), 16, 0, 0); } while (0)
#define PG8_LDA(dst, b, h) do { _Pragma("unroll") for (int m = 0; m < 4; ++m) _Pragma("unroll") for (int k = 0; k < 2; ++k) dst[m][k] = *(const PG8_LAS bf16x8*)(lds + PG8_SA(b, h) + aoff + m * 2048 + k * 1024); } while (0)
#define PG8_LDB(dst, b, h) do { _Pragma("unroll") for (int n = 0; n < 2; ++n) _Pragma("unroll") for (int k = 0; k < 2; ++k) dst[n][k] = *(const PG8_LAS bf16x8*)(lds + PG8_SB(b, h) + boff + n * 2048 + k * 1024); } while (0)
#define PG8_MMA(ai, bj, At, Bt) do { __builtin_amdgcn_s_setprio(1); _Pragma("unroll") for (int m = 0; m < 4; ++m) _Pragma("unroll") for (int n = 0; n < 2; ++n) _Pragma("unroll") for (int k = 0; k < 2; ++k) \
        { if constexpr (I8) acc[ai][bj][m][n] = __builtin_bit_cast(f32x4, __builtin_amdgcn_mfma_i32_16x16x64_i8(__builtin_bit_cast(i32x4, Bt[n][k]), __builtin_bit_cast(i32x4, At[m][k]), __builtin_bit_cast(i32x4, acc[ai][bj][m][n]), 0, 0, 0)); \
          else acc[ai][bj][m][n] = __builtin_amdgcn_mfma_f32_16x16x32_bf16(Bt[n][k], At[m][k], acc[ai][bj][m][n], 0, 0, 0); } __builtin_amdgcn_s_setprio(0); } while (0)
#define PG8_WAIT_V(n) asm volatile("s_waitcnt vmcnt(" #n ")" ::: "memory")
#define PG8_WAIT_L(n) asm volatile("s_waitcnt lgkmcnt(" #n ")" ::: "memory")
#define PG8_BAR __builtin_amdgcn_s_barrier()
#define PG8_SCHED __builtin_amdgcn_sched_barrier(0)
    PROF_START(22, lds, wid);
    Unit cur, nxt; int ui = 0;
    if (!S.next(0, cur)) return;
    f32x4 acc[2][2][4][2];
#pragma unroll
    for (int a = 0; a < 2; ++a)
#pragma unroll
        for (int b = 0; b < 2; ++b)
#pragma unroll
            for (int m = 0; m < 4; ++m)
#pragma unroll
                for (int n = 0; n < 2; ++n) acc[a][b][m][n] = (f32x4){0.f, 0.f, 0.f, 0.f};
    bf16x8 At[4][2], B0[2][2], B1[2][2];
    const char* cA = (const char*)g.A + (size_t)cur.pm * tstep; const char* cB = (const char*)g.Bt + (size_t)cur.pn * tstep;
    S.a_ready(cur);
    if constexpr (SP2) {
        PG8_STAGE(PG8_SB(0, 0), cB, voffB); PG8_STAGE(PG8_SB(0, 1), cB + hstep, voffB); PG8_STAGE(PG8_SA(0, 0), cA, voffA); PG8_STAGE(PG8_SA(0, 1), cA + hstep, voffA);
        if (wr == 1) PG8_BAR;
        PG8_WAIT_V(2); PG8_BAR;
        PG8_STAGE(PG8_SB(1, 0), cB + kstep, voffB); PG8_STAGE(PG8_SA(1, 0), cA + kstep, voffA); PG8_STAGE(PG8_SB(1, 1), cB + hstep + kstep, voffB);
        PG8_WAIT_V(6); PG8_BAR;
    } else {
        PG8_STAGE(PG8_SB(0, 0), cB, voffB); PG8_STAGE(PG8_SA(0, 0), cA, voffA); PG8_STAGE(PG8_SB(0, 1), cB + hstep, voffB); PG8_STAGE(PG8_SA(0, 1), cA + hstep, voffA);
        if (wr == 1) PG8_BAR;
        PG8_WAIT_V(4); PG8_BAR;
        PG8_STAGE(PG8_SB(1, 0), cB + kstep, voffB); PG8_STAGE(PG8_SA(1, 0), cA + kstep, voffA); PG8_STAGE(PG8_SB(1, 1), cB + hstep + kstep, voffB);
        PG8_WAIT_V(6); PG8_BAR;
    }
    PROF_STOP(22, lds, wid);
    for (;;) {
        const bool has_next = S.next(ui + 1, nxt);
        const char* nA = has_next ? (const char*)g.A + (size_t)nxt.pm * tstep : cA; const char* nB = has_next ? (const char*)g.Bt + (size_t)nxt.pn * tstep : cB;
        PROF_START(8, lds, wid);
        asm volatile(".p2align 8");
        for (int t = 0; t < nt; t += 2) {
            const bool last = (t == nt - 2);
            const char* a1 = cA + (size_t)(t + 1) * kstep;
            const char* a2 = last ? nA : cA + (size_t)(t + 2) * kstep; const char* b2 = last ? nB : cB + (size_t)(t + 2) * kstep;
            const char* a3 = a2 + kstep; const char* b3 = b2 + kstep;
            if (last && has_next) S.a_ready(nxt);
            if constexpr (SP2) {
            PG8_LDB(B0, 0, 0); PG8_LDB(B1, 0, 1); PG8_SCHED; PG8_LDA(At, 0, 0); PG8_STAGE(PG8_SA(1, 1), a1 + hstep, voffA);
            PG8_WAIT_V(8); PG8_WAIT_L(0); PG8_BAR; PG8_MMA(0, 0, At, B0); PG8_MMA(0, 1, At, B1); PG8_BAR; PG8_SCHED;
            PG8_LDA(At, 0, 1); PG8_STAGE(PG8_SB(0, 0), b2, voffB); PG8_STAGE(PG8_SB(0, 1), b2 + hstep, voffB); PG8_STAGE(PG8_SA(0, 0), a2, voffA);
            PG8_WAIT_V(8); PG8_WAIT_L(0); PG8_BAR; PG8_MMA(1, 0, At, B0); PG8_MMA(1, 1, At, B1); PG8_BAR; PG8_SCHED;
            PG8_LDB(B0, 1, 0); PG8_LDB(B1, 1, 1); PG8_SCHED; PG8_LDA(At, 1, 0); PG8_STAGE(PG8_SA(0, 1), a2 + hstep, voffA);
            PG8_WAIT_V(8); PG8_WAIT_L(0); PG8_BAR; PG8_MMA(0, 0, At, B0); PG8_MMA(0, 1, At, B1); PG8_BAR; PG8_SCHED;
            PG8_LDA(At, 1, 1); PG8_STAGE(PG8_SB(1, 0), b3, voffB); PG8_STAGE(PG8_SB(1, 1), b3 + hstep, voffB); PG8_STAGE(PG8_SA(1, 0), a3, voffA);
            PG8_WAIT_V(8); PG8_WAIT_L(0); PG8_BAR; PG8_MMA(1, 0, At, B0); PG8_MMA(1, 1, At, B1); PG8_BAR; PG8_SCHED;
            } else {
            PG8_LDB(B0, 0, 0); PG8_SCHED; PG8_LDA(At, 0, 0); PG8_STAGE(PG8_SA(1, 1), a1 + hstep, voffA);
            PG8_WAIT_L(8); PG8_BAR; PG8_WAIT_L(0); PG8_MMA(0, 0, At, B0); PG8_BAR; PG8_SCHED;
            PG8_LDB(B1, 0, 1); PG8_STAGE(PG8_SB(0, 0), b2, voffB);
            PG8_BAR; PG8_WAIT_L(0); PG8_MMA(0, 1, At, B1); PG8_BAR;
            PG8_LDA(At, 0, 1); PG8_STAGE(PG8_SA(0, 0), a2, voffA);
            PG8_BAR; PG8_WAIT_L(0); PG8_MMA(1, 0, At, B0); PG8_BAR; PG8_SCHED;
            PG8_STAGE(PG8_SB(0, 1), b2 + hstep, voffB);
            PG8_WAIT_V(6); PG8_BAR; PG8_MMA(1, 1, At, B1); PG8_BAR;
            PG8_LDB(B0, 1, 0); PG8_SCHED; PG8_LDA(At, 1, 0); PG8_STAGE(PG8_SA(0, 1), a2 + hstep, voffA);
            PG8_WAIT_L(8); PG8_BAR; PG8_WAIT_L(0); PG8_MMA(0, 0, At, B0); PG8_BAR; PG8_SCHED;
            PG8_LDB(B1, 1, 1); PG8_STAGE(PG8_SB(1, 0), b3, voffB);
            PG8_BAR; PG8_WAIT_L(0); PG8_MMA(0, 1, At, B1); PG8_BAR;
            PG8_LDA(At, 1, 1); PG8_STAGE(PG8_SA(1, 0), a3, voffA);
            PG8_BAR; PG8_WAIT_L(0); PG8_MMA(1, 0, At, B0); PG8_BAR; PG8_SCHED;
            PG8_STAGE(PG8_SB(1, 1), b3 + hstep, voffB);
            PG8_WAIT_V(6); PG8_BAR; PG8_MMA(1, 1, At, B1); PG8_BAR;
            }
        }
        PROF_STOP(8, lds, wid); PROF_START(14, lds, wid);
        if constexpr (ALIGN_EPI) { if (wr == 0) PG8_BAR; }
        PROF_STOP(14, lds, wid); PROF_START(1, lds, wid);
        if constexpr (!Epi::AFTER_DRAIN) { E(acc, cur, wr, wc, fr, fq, lds, wid, lane); S.done(cur); }
        PROF_STOP(1, lds, wid);
        if (!has_next) break;
#pragma unroll
        for (int a = 0; a < 2; ++a)
#pragma unroll
            for (int b = 0; b < 2; ++b)
#pragma unroll
                for (int m = 0; m < 4; ++m)
#pragma unroll
                    for (int n = 0; n < 2; ++n) acc[a][b][m][n] = (f32x4){0.f, 0.f, 0.f, 0.f};
        cur = nxt; cA = nA; cB = nB; ++ui;
        if constexpr (ALIGN_EPI) { if (wr == 1) PG8_BAR; }
    }
    PROF_START(23, lds, wid);
    PG8_WAIT_V(0);
    if constexpr (!ALIGN_EPI) { if (wr == 0) PG8_BAR; }
    PG8_BAR;
    PROF_STOP(23, lds, wid); PROF_START(11, lds, wid);
    if constexpr (Epi::AFTER_DRAIN) { E.fused(acc, cur, wr, wc, fr, fq, lds, wid, lane); S.done(cur); }
    PROF_STOP(11, lds, wid);
#undef PG8_SA
#undef PG8_SB
#undef PG8_STAGE
#undef PG8_LDA
#undef PG8_LDB
#undef PG8_MMA
#undef PG8_WAIT_V
#undef PG8_WAIT_L
#undef PG8_BAR
#undef PG8_SCHED
}
}

constexpr int NWAVES = 8;
#ifndef MK_N_LAUNCHES
#define MK_N_LAUNCHES 1
#endif
constexpr int N_LAUNCHES = MK_N_LAUNCHES;
constexpr int N_PHASES = 5;

constexpr int D = 1024, BATCH = 2, SEQ = 8192, DEPTH = 2, M = BATCH * SEQ, NIN = 3072;
constexpr size_t MiB = 1u << 20;
constexpr size_t WS_CTL = 0, CTL_ZERO_BYTES = 192 * 1024;
constexpr size_t WS_W1T = 2 * MiB;
constexpr size_t WS_W2T = 14 * MiB;
constexpr size_t WS_SSQ = 18 * MiB;
constexpr size_t WS_XSLOT = 19 * MiB;
constexpr size_t WS_HALO = 20 * MiB;
constexpr size_t WS_XB = 32 * MiB;
constexpr size_t WS_Y = 64 * MiB;
constexpr size_t WS_HGA = 96 * MiB;
constexpr size_t WS_W1Q = 97 * MiB;
constexpr size_t WS_SW = 100 * MiB;
constexpr size_t WS_XQ = 101 * MiB;
constexpr size_t WS_SA = 117 * MiB;
constexpr size_t WS_XS2 = 118 * MiB;
constexpr size_t WS_END = 119 * MiB;
constexpr int CW_TMO = 0, CW_BAR = 4096, CW_CNT = 8192, CW_XCC = 12288, CW_FLAG = 16384, CW_QCNT = 44160  ;
static_assert(CW_FLAG + 2 * 768 * 16 <= CW_QCNT && (CW_QCNT + 64) * 4 <= (int)CTL_ZERO_BYTES && (CW_FLAG + 2 * 768 * 16) * 4 <= (int)CTL_ZERO_BYTES, "ctl words inside the memset region");

constexpr int RING_BYTES = 131072;
constexpr int HB_OFF = RING_BYTES;
constexpr int MISC_OFF = pg8::EPI_MISC_OFF;
constexpr int LDS_BYTES = pg8::EPI_LDS_END;
constexpr int SCR_STRIDE = 17408;
static_assert(pg8::HB_BYTES <= 25600 && 8 * SCR_STRIDE <= MISC_OFF && LDS_BYTES <= 160 * 1024, "LDS map");

#define GAS __attribute__((address_space(1)))
#define LAS __attribute__((address_space(3)))
typedef unsigned short bf16;
typedef unsigned v4u __attribute__((ext_vector_type(4)));
typedef unsigned v2u __attribute__((ext_vector_type(2)));
typedef float f32x4 __attribute__((ext_vector_type(4)));
typedef float f32x16 __attribute__((ext_vector_type(16)));
#define LDS_WAIT() asm volatile("s_waitcnt lgkmcnt(0)" ::: "memory")
#define VM_WAIT() asm volatile("s_waitcnt vmcnt(0)" ::: "memory")
__device__ __forceinline__ unsigned f2bf(float f) { unsigned u = __builtin_bit_cast(unsigned, f); return (u + 0x7fffu + ((u >> 16) & 1u)) >> 16; }
__device__ __forceinline__ unsigned pk2(float lo, float hi) { return f2bf(lo) | (f2bf(hi) << 16); }

#define XB_TMO      128
#define XB_XCNT(j)  (256  + 64 * (j))
#define XB_XSUB(j)  (1280 + 64 * (j))
#define XB_XGEN(j)  (2304 + 64 * (j))
#define XB_TOP      3328
#define XB_TOPGEN   3392
#define XCD_BAR_WORDS 3456
#define XB_SPIN_CAP (1u << 18)

__device__ __forceinline__ unsigned xb_ld(unsigned* p)              { return __hip_atomic_load(p, __ATOMIC_RELAXED, __HIP_MEMORY_SCOPE_AGENT); }
__device__ __forceinline__ unsigned xb_add(unsigned* p, unsigned v) { return __hip_atomic_fetch_add(p, v, __ATOMIC_RELAXED, __HIP_MEMORY_SCOPE_AGENT); }
__device__ __forceinline__ unsigned xb_xcc_id() { return (unsigned)__builtin_amdgcn_s_getreg((3 << 11) | 20) & 0xFu; }
#define XB_SPIN(cond, bar) do { unsigned _sp = 0; while (cond) { __builtin_amdgcn_s_sleep(1); \
    if ((++_sp & 255u) == 0u) { if (xb_ld(&(bar)[XB_TMO])) break; if (_sp > XB_SPIN_CAP) { atomicAdd(&(bar)[XB_TMO], 1u); break; } } } } while (0)

struct XcdBarrier {
    unsigned* bar; unsigned x;
    volatile LAS unsigned* st;
};

__device__ __forceinline__ XcdBarrier xcd_barrier_post(unsigned* bar, volatile LAS unsigned* st) {
    XcdBarrier b; b.bar = bar; b.x = xb_xcc_id(); b.st = st;
    if (threadIdx.x == 0) (void)xb_add(&bar[XB_XCNT(b.x)], 1u);
    return b;
}
__device__ __forceinline__ void xcd_barrier_complete(unsigned* bar, unsigned x, unsigned& nloc, unsigned& nx) {
    const unsigned G = gridDim.x * gridDim.y * gridDim.z;
    unsigned sum, cnt, mine, sp = 0u;
    for (;;) {
        sum = 0u; cnt = 0u; mine = 0u;
#pragma unroll
        for (unsigned j = 0; j < 16; ++j) { const unsigned c = xb_ld(&bar[XB_XCNT(j)]); sum += c; cnt += (c > 0u) ? 1u : 0u; mine = (j == x) ? c : mine; }
        if (sum == G) break;
        __builtin_amdgcn_s_sleep(1);
        if ((++sp & 255u) == 0u) { if (xb_ld(&bar[XB_TMO])) break; if (sp > XB_SPIN_CAP) { atomicAdd(&bar[XB_TMO], 1u); break; } }
    }
    nloc = mine > 0u ? mine : 1u; nx = cnt > 0u ? cnt : 1u;
}

__device__ __forceinline__ void xcd_barrier(const XcdBarrier& b, bool leader_wb = true, bool self_wb = false) {
    asm volatile("s_waitcnt vmcnt(0)" ::: "memory");
    __syncthreads();
    if (threadIdx.x == 0) {
        unsigned* bar = b.bar;
        if (self_wb) { __builtin_amdgcn_fence(__ATOMIC_RELEASE, "agent"); asm volatile("s_waitcnt vmcnt(0)" ::: "memory"); }
        __builtin_amdgcn_s_waitcnt(0);
        unsigned nloc = b.st[0], nx = b.st[1];
        if (nloc == 0u) { xcd_barrier_complete(bar, b.x, nloc, nx); b.st[0] = nloc; b.st[1] = nx; }
        const unsigned old = xb_add(&bar[XB_XSUB(b.x)], 1u);
        const unsigned gen = old / nloc;
        if (old + 1u == (gen + 1u) * nloc) {
            if (leader_wb) __builtin_amdgcn_fence(__ATOMIC_RELEASE, "agent");
            asm volatile("s_waitcnt vmcnt(0)" ::: "memory");
            const unsigned og = xb_add(&bar[XB_TOP], 1u);
            const unsigned tg = og / nx;
            if (og + 1u == (tg + 1u) * nx) xb_add(&bar[XB_TOPGEN], 1u);
            else XB_SPIN(xb_ld(&bar[XB_TOPGEN]) == tg, bar);
            __builtin_amdgcn_fence(__ATOMIC_ACQUIRE, "agent");
            xb_add(&bar[XB_XGEN(b.x)], 1u);
            asm volatile("s_waitcnt vmcnt(0)" ::: "memory");
        } else {
            XB_SPIN(xb_ld(&bar[XB_XGEN(b.x)]) == gen, bar);
            __builtin_amdgcn_fence(__ATOMIC_ACQUIRE, "agent");
            asm volatile("s_waitcnt vmcnt(0)" ::: "memory");
        }
    }
    __syncthreads();
}


__device__ __forceinline__ void seam_arrive(unsigned* word, bool fence) {
    asm volatile("s_waitcnt vmcnt(0)" ::: "memory");
    __syncthreads();
    if (threadIdx.x == 0) {
        if (fence) { __builtin_amdgcn_fence(__ATOMIC_RELEASE, "agent"); asm volatile("s_waitcnt vmcnt(0)" ::: "memory"); }
        (void)__hip_atomic_fetch_add(word, 1u, __ATOMIC_RELAXED, __HIP_MEMORY_SCOPE_AGENT);
    }
}
__device__ __forceinline__ void seam_wait(unsigned* word, unsigned want, unsigned* tmo, unsigned code) {
    if (threadIdx.x < 64) { unsigned sp = 0;
        __builtin_amdgcn_fence(__ATOMIC_ACQUIRE, "agent");
        while ((unsigned)__builtin_amdgcn_readfirstlane(__hip_atomic_load(word, __ATOMIC_RELAXED, __HIP_MEMORY_SCOPE_AGENT)) < want) { __builtin_amdgcn_s_sleep(1);
            if (++sp > (1u << 20)) { if (threadIdx.x == 0) __hip_atomic_store(tmo, code, __ATOMIC_RELAXED, __HIP_MEMORY_SCOPE_AGENT); break; } }
        asm volatile("s_waitcnt vmcnt(0)" ::: "memory"); }
    __syncthreads();
}

__device__ __forceinline__ float wave_sum(float v) {
#pragma unroll
    for (int o = 1; o < 64; o <<= 1) v += __shfl_xor(v, o);
    return v;
}
__device__ __forceinline__ int w1_srccol(int n) {
    const int pn = n >> 8, c = n & 255, bj = c >> 7, wc = (c >> 5) & 3, nn = (c >> 4) & 1, fq = (c >> 2) & 3, j = c & 3;
    if (pn < 8) return (2 * bj + nn) * 512 + 64 * pn + 16 * wc + 4 * fq + j;
    if (bj == 0) return -1;
    return 2560 + 128 * (pn - 8) + 32 * wc + 8 * fq + 4 * nn + j;
}
struct TrItem { const float* W; const float* gs; bf16* WT; int ldw, n0, srccol, k0; };
__device__ __forceinline__ void tr_load(const TrItem& d, int lane, float (&v)[32]) {
#pragma unroll
    for (int i = 0; i < 32; ++i) v[i] = __builtin_nontemporal_load(d.W + (size_t)(d.k0 + 2 * i + (lane >> 5)) * d.ldw + d.srccol);
}
__device__ __forceinline__ void tr_finish(const TrItem& d, const float (&v)[32], LAS float* scr, int lane) {
    const int c = lane & 7;
    f32x4 g0 = {1.f, 1.f, 1.f, 1.f}, g1 = g0;
    if (d.gs) { g0 = *(const f32x4*)(d.gs + d.k0 + 8 * c); g1 = *(const f32x4*)(d.gs + d.k0 + 8 * c + 4); }
#pragma unroll
    for (int i = 0; i < 32; ++i) scr[(2 * i + (lane >> 5)) * 33 + (lane & 31)] = v[i];
    LDS_WAIT(); asm volatile("" ::: "memory");
#pragma unroll
    for (int j = 0; j < 4; ++j) { const int n = (lane >> 3) + 8 * j; const LAS float* s = scr + (8 * c) * 33 + n;
        v4u o; o.x = pk2(s[0 * 33] * g0[0], s[1 * 33] * g0[1]); o.y = pk2(s[2 * 33] * g0[2], s[3 * 33] * g0[3]); o.z = pk2(s[4 * 33] * g1[0], s[5 * 33] * g1[1]); o.w = pk2(s[6 * 33] * g1[2], s[7 * 33] * g1[3]);
        asm volatile("global_store_dwordx4 %0, %1, off sc1\n\ts_nop 1" :: "v"(d.WT + (size_t)(d.n0 + n) * D + d.k0 + 8 * c), "v"(o) : "memory");
    }
    LDS_WAIT(); asm volatile("" ::: "memory");
}
__device__ __forceinline__ void p0_pool_item(const float* win, const float* gpre, const float* wpool, bf16* W1T, LAS float* scr, int item, int lane) {
    const int db = item & 3, g = (item >> 2) & 3, kb = item >> 4;
    const int k0 = 32 * kb, d0 = 32 * db, i = lane & 31, h = lane >> 5;
    float b[64];
#pragma unroll
    for (int s = 0; s < 64; ++s) b[s] = wpool[(size_t)(g * 128 + 2 * s + h) * 128 + d0 + i];
#pragma unroll
    for (int r = 0; r < 16; ++r) { const int kk = 2 * r + h; const f32x4 v = *(const f32x4*)(win + (size_t)(k0 + kk) * NIN + 2048 + 128 * g + 4 * i); const float gs = gpre[k0 + kk];
        LAS float* d = scr + kk * 129 + 4 * i; d[0] = v[0] * gs; d[1] = v[1] * gs; d[2] = v[2] * gs; d[3] = v[3] * gs; }
    LDS_WAIT(); asm volatile("" ::: "memory");
    f32x16 acc;
#pragma unroll
    for (int r = 0; r < 16; ++r) acc[r] = 0.f;
#pragma unroll
    for (int s = 0; s < 64; ++s) { const float a = scr[i * 129 + 2 * s + h]; acc = __builtin_amdgcn_mfma_f32_32x32x2f32(a, b[s], acc, 0, 0, 0); }
    const int d = d0 + i, n = 256 * (8 + g) + 32 * (d >> 5) + 16 * ((d >> 2) & 1) + 4 * ((d >> 3) & 3) + (d & 3);
#pragma unroll
    for (int q = 0; q < 4; ++q) { v2u o; o.x = pk2(acc[4 * q + 0], acc[4 * q + 1]); o.y = pk2(acc[4 * q + 2], acc[4 * q + 3]); __hip_atomic_store((unsigned long long*)(W1T + (size_t)n * D + k0 + 8 * q + 4 * h), ((unsigned long long)o.y << 32) | o.x, __ATOMIC_RELAXED, __HIP_MEMORY_SCOPE_AGENT); }
    LDS_WAIT(); asm volatile("" ::: "memory");
}

struct Args { const float* in[9]; float* out; unsigned char* ws; int ph_lo, ph_hi; };

__device__ __forceinline__ void p0_prologue(const Args& a, LAS unsigned char* lds, int gw, int NGW, int wave, int lane) {
    LAS float* scr = (LAS float*)(lds + wave * SCR_STRIDE);
    const float* x = a.in[0]; const float* pre_norm = a.in[1]; const float* w_in = a.in[2]; const float* w_pool = a.in[5]; const float* w_out = a.in[7];
    bf16* W1T = (bf16*)(a.ws + WS_W1T); bf16* W2T = (bf16*)(a.ws + WS_W2T); bf16* XB = (bf16*)(a.ws + WS_XB); float* SSQ = (float*)(a.ws + WS_SSQ);
    constexpr int I_POOL = DEPTH * 512, I_W1 = DEPTH * 80 * 16, I_W2 = DEPTH * 32 * 16, I_TR = I_W1 + I_W2;
    { unsigned long long* xs = (unsigned long long*)(a.ws + WS_XSLOT);
      for (int i = gw * 64 + lane; i < DEPTH * M * 4; i += NGW * 64) __hip_atomic_store(xs + i, 0ull, __ATOMIC_RELAXED, __HIP_MEMORY_SCOPE_AGENT);
      unsigned long long* x2 = (unsigned long long*)(a.ws + WS_XS2);
      for (int i = gw * 64 + lane; i < M * 4; i += NGW * 64) __hip_atomic_store(x2 + i, 0ull, __ATOMIC_RELAXED, __HIP_MEMORY_SCOPE_AGENT);
      unsigned long long* hz = (unsigned long long*)(a.ws + WS_HGA);
      for (int i = gw * 64 + lane; i < DEPTH * 8 * 64 * 128; i += NGW * 64) __hip_atomic_store(hz + i, 0ull, __ATOMIC_RELAXED, __HIP_MEMORY_SCOPE_AGENT); }
#define P0_TR_DESC(d, r_) do { int r = (r_); \
        if (r < I_W1) { const int l = r / 1280, q = r % 1280, nbi = q % 80, kb = q / 80;     \
            const int n0 = nbi < 64 ? 32 * nbi : 256 * (8 + ((nbi - 64) >> 2)) + 128 + 32 * ((nbi - 64) & 3); \
            d.W = w_in + (size_t)l * D * NIN; d.gs = pre_norm + l * D; d.WT = W1T + (size_t)l * NIN * D; d.ldw = NIN; d.n0 = n0; d.srccol = w1_srccol(n0 + (lane & 31)); d.k0 = 64 * kb; } \
        else { r -= I_W1; const int l = r >> 9, q = r & 511, nb = q & 31, kb = q >> 5; \
            d.W = w_out + (size_t)l * D * D; d.gs = nullptr; d.WT = W2T + (size_t)l * D * D; d.ldw = D; d.n0 = 32 * nb; d.srccol = 32 * nb + (lane & 31); d.k0 = 64 * kb; } } while (0)
    if (NGW == 2048) {
        if (gw < I_POOL) {
            TrItem d; float v[32]; const bool has = gw < I_TR - 3 * 1024;
            if (has) { P0_TR_DESC(d, 3 * 1024 + gw); tr_load(d, lane, v); }
            { const int l = gw >> 9; p0_pool_item(w_in + (size_t)l * D * NIN, pre_norm + l * D, w_pool + (size_t)l * 4 * 128 * 128, W1T + (size_t)l * NIN * D, scr, gw & 511, lane); }
            if (has) tr_finish(d, v, scr, lane);
        } else {
            TrItem d0, d1, d2; float v0[32], v1[32], v2[32]; const int t0 = (gw - 1024) * 3;
            P0_TR_DESC(d0, t0); tr_load(d0, lane, v0); P0_TR_DESC(d1, t0 + 1); tr_load(d1, lane, v1); P0_TR_DESC(d2, t0 + 2); tr_load(d2, lane, v2);
            tr_finish(d0, v0, scr, lane); tr_finish(d1, v1, scr, lane); tr_finish(d2, v2, scr, lane);
        }
    } else {
        for (int it = gw; it < I_POOL + I_TR; it += NGW) {
            if (it < I_POOL) { const int l = it >> 9; p0_pool_item(w_in + (size_t)l * D * NIN, pre_norm + l * D, w_pool + (size_t)l * 4 * 128 * 128, W1T + (size_t)l * NIN * D, scr, it & 511, lane); }
            else { TrItem d; float v[32]; P0_TR_DESC(d, it - I_POOL); tr_load(d, lane, v); tr_finish(d, v, scr, lane); }
        }
    }
#undef P0_TR_DESC
    const int xstep = (NGW == 2048) ? 1 : NGW, xc = gw >> 3;
    const int xfirst = (NGW == 2048) ? (8 * (xc & 7) + ((xc >> 3) & 7)) * 256 + (xc >> 6) * 64 + (gw & 7) * 8 : gw, xend = (NGW == 2048) ? xfirst + 8 : M;
    for (int r0 = xfirst; r0 < xend; r0 += 4 * xstep) {
        f32x4 v[4][4];
#pragma unroll
        for (int q = 0; q < 4; ++q) { const f32x4* xr = (const f32x4*)(x + (size_t)(r0 + q * xstep) * D) + lane;
#pragma unroll
            for (int j = 0; j < 4; ++j) v[q][j] = (r0 + q * xstep < M) ? __builtin_nontemporal_load(xr + 64 * j) : (f32x4){0.f, 0.f, 0.f, 0.f}; }
#pragma unroll
        for (int q = 0; q < 4; ++q) { const int r = r0 + q * xstep; if (r >= M) break; float s = 0.f;
#pragma unroll
            for (int j = 0; j < 4; ++j) s += (v[q][j][0] * v[q][j][0] + v[q][j][1] * v[q][j][1]) + (v[q][j][2] * v[q][j][2] + v[q][j][3] * v[q][j][3]);
            s = wave_sum(s);
            if (lane == 0) *(f32x4*)(SSQ + (size_t)r * 4) = (f32x4){s, 0.f, 0.f, 0.f};
            v2u* o8 = (v2u*)(XB + (size_t)r * D) + lane;
#pragma unroll
            for (int j = 0; j < 4; ++j) { v2u o; o.x = pk2(v[q][j][0], v[q][j][1]); o.y = pk2(v[q][j][2], v[q][j][3]); o8[64 * j] = o; } }
    }
}

__device__ __forceinline__ void p0_quantize_w1(const Args& a, int gw, int NGW, int lane) {
    const bf16* W1T1 = (const bf16*)(a.ws + WS_W1T) + (size_t)NIN * D; signed char* W1Q = (signed char*)(a.ws + WS_W1Q); float* SW = (float*)(a.ws + WS_SW);
    unsigned* ctl = (unsigned*)(a.ws + WS_CTL);
    v4u p[2][2]; bool has[2];
#pragma unroll
    for (int q = 0; q < 2; ++q) { const int n = gw + q * NGW; has[q] = n < NIN;
        if (has[q]) { p[q][0] = *(const v4u*)(W1T1 + (size_t)n * D + 16 * lane); p[q][1] = *(const v4u*)(W1T1 + (size_t)n * D + 16 * lane + 8); } else { p[q][0] = (v4u){0u, 0u, 0u, 0u}; p[q][1] = p[q][0]; } }
#pragma unroll
    for (int q = 0; q < 2; ++q) { if (!has[q]) continue; const int n = gw + q * NGW;
        const unsigned w[8] = {p[q][0].x, p[q][0].y, p[q][0].z, p[q][0].w, p[q][1].x, p[q][1].y, p[q][1].z, p[q][1].w}; float mx = 0.f;
#pragma unroll
        for (int i = 0; i < 8; ++i) mx = fmaxf(mx, fmaxf(fabsf(__uint_as_float(w[i] << 16)), fabsf(__uint_as_float(w[i] & 0xffff0000u))));
#pragma unroll
        for (int o = 1; o < 64; o <<= 1) mx = fmaxf(mx, __shfl_xor(mx, o));
        const float cm = fmaxf(mx, 1e-30f), qs = 127.0f / cm; unsigned f[16];
#pragma unroll
        for (int i = 0; i < 8; ++i) { f[2 * i] = __float_as_uint(fmaf(__uint_as_float(w[i] << 16), qs, 12582912.0f)); f[2 * i + 1] = __float_as_uint(fmaf(__uint_as_float(w[i] & 0xffff0000u), qs, 12582912.0f)); }
        v4u ov;
        ov.x = __builtin_amdgcn_perm(__builtin_amdgcn_perm(f[3], f[2], 0x0c0c0400u), __builtin_amdgcn_perm(f[1], f[0], 0x0c0c0400u), 0x05040100u);
        ov.y = __builtin_amdgcn_perm(__builtin_amdgcn_perm(f[7], f[6], 0x0c0c0400u), __builtin_amdgcn_perm(f[5], f[4], 0x0c0c0400u), 0x05040100u);
        ov.z = __builtin_amdgcn_perm(__builtin_amdgcn_perm(f[11], f[10], 0x0c0c0400u), __builtin_amdgcn_perm(f[9], f[8], 0x0c0c0400u), 0x05040100u);
        ov.w = __builtin_amdgcn_perm(__builtin_amdgcn_perm(f[15], f[14], 0x0c0c0400u), __builtin_amdgcn_perm(f[13], f[12], 0x0c0c0400u), 0x05040100u);
        asm volatile("global_store_dwordx4 %0, %1, off sc1\n\ts_nop 1" :: "v"(W1Q + (size_t)n * D + 16 * lane), "v"(ov) : "memory");
        if (lane == 0) __hip_atomic_store(SW + n, cm * (1.0f / 127.0f), __ATOMIC_RELAXED, __HIP_MEMORY_SCOPE_AGENT);
    }
    asm volatile("s_waitcnt vmcnt(0)" ::: "memory");
    __syncthreads();
    if (threadIdx.x == 0) (void)__hip_atomic_fetch_add(ctl + CW_QCNT, 1u, __ATOMIC_RELAXED, __HIP_MEMORY_SCOPE_AGENT);
}

__global__ void __launch_bounds__(NWAVES * 64, 2) mk_fwd(Args args) {
    extern __shared__ __attribute__((aligned(16))) unsigned char lds_raw[];
    LAS unsigned char* lds = (LAS unsigned char*)lds_raw;
    volatile LAS unsigned* MISC = (volatile LAS unsigned*)(lds + MISC_OFF);
    const int tid = threadIdx.x, lane = tid & 63, wave = __builtin_amdgcn_readfirstlane(tid >> 6);
    const int G = gridDim.x;
    unsigned char* ws = args.ws;
    unsigned* ctl = (unsigned*)(ws + WS_CTL);
    if (tid < 64) MISC[tid] = 0u;
    __syncthreads();
    if (tid == 0) __hip_atomic_store(ctl + CW_XCC + blockIdx.x, xb_xcc_id() + 1u, __ATOMIC_RELAXED, __HIP_MEMORY_SCOPE_AGENT);
    XcdBarrier bar; bar.bar = ctl + CW_BAR; bar.x = 0; bar.st = nullptr;
    if (N_LAUNCHES == 1) bar = xcd_barrier_post(ctl + CW_BAR, MISC + 8);
#define GRID_BAR() do { if (N_LAUNCHES == 1) xcd_barrier(bar); } while (0)
    const int lo = args.ph_lo, hi = args.ph_hi;
#define IN(k) (lo <= (k) && (k) < hi)
    bf16* W1T = (bf16*)(ws + WS_W1T); bf16* W2T = (bf16*)(ws + WS_W2T); bf16* XB = (bf16*)(ws + WS_XB); bf16* Y = (bf16*)(ws + WS_Y);
    float* SSQ = (float*)(ws + WS_SSQ);

#define PHASE_P0() do { if (IN(0)) { PROF_START(25, lds, wave); p0_prologue(args, lds, blockIdx.x * NWAVES + wave, G * NWAVES, wave, lane); PROF_STOP(25, lds, wave); PROF_START(24, lds, wave); P0_PARTNERS(); if (N_LAUNCHES == 1) { if (quad) xcd_barrier(bar, false, MISC[17] != 0u); else xcd_barrier(bar); } PROF_STOP(24, lds, wave); p0_quantize_w1(args, blockIdx.x * NWAVES + wave, G * NWAVES, lane); } } while (0)
    int my_pm; { pg8::StaticOrder S; S.init(M, NIN, G, (int)blockIdx.x); pg8::Unit u0, u1; S.next(0, u0); my_pm = u0.pm; bool same = true; for (int i = 1; S.next(i, u1); ++i) same &= (u1.pm == u0.pm);
                 pg8::StaticOrder S2; S2.init(M, D, G, (int)blockIdx.x); S2.next(0, u1); same &= (u1.pm == u0.pm) && G == 256; if (!same) my_pm = -1; }
    const bool quad = (MK_QUAD != 0) && N_LAUNCHES == 1 && my_pm >= 0;
    unsigned* seamw = ctl + CW_CNT + (my_pm < 0 ? 0 : my_pm) * 16;
#define SEAM_DONE(s_) do { PROF_START(21, lds, wave); if (quad) seam_arrive(seamw + (s_) * 1024, MISC[17] != 0u); else GRID_BAR(); PROF_STOP(21, lds, wave); } while (0)
#define SEAM_WAIT(s_) do { PROF_START(20, lds, wave); if (quad) seam_wait(seamw + (s_) * 1024, 4u, ctl + CW_TMO, 0x600u + (s_)); PROF_STOP(20, lds, wave); } while (0)
#define PHASE_G1(l) do { if (IN(1 + 2 * (l))) { \
            if ((l) > 0) SEAM_WAIT(1); \
            if ((l) > 0) { if (tid < 64) { unsigned sp = 0; while ((unsigned)__builtin_amdgcn_readfirstlane(__hip_atomic_load(ctl + CW_QCNT, __ATOMIC_RELAXED, __HIP_MEMORY_SCOPE_AGENT)) < (unsigned)G && ++sp < (1u << 20)) __builtin_amdgcn_s_sleep(1); } __syncthreads(); }     \
            pg8::Gemm g{(l) ? (const bf16*)(ws + WS_XQ) : XB, (l) ? (const bf16*)(ws + WS_W1Q) : W1T, M, NIN, (l) ? D / 2 : D};     \
            pg8::StaticOrder S; S.init(M, NIN, G, (int)blockIdx.x); \
            pg8::EpiMixT<(l) == 1> E{Y, SSQ, args.in[3] + (size_t)(l) * 3 * 512, args.in[4] + (size_t)(l) * 512, args.in[6] + (size_t)(l) * 512, \
                          (float*)(ws + WS_HALO) + (size_t)(l) * 768 * pg8::HALO_TILE, ctl + CW_FLAG + (l) * 768 * 16, ctl + CW_TMO, (unsigned)((l) + 1), (const float*)(ws + WS_SA), (const float*)(ws + WS_SW), (unsigned long long*)(ws + WS_HGA) + (size_t)(l) * 8 * 64 * 128}; \
            pg8::gemm_phase<pg8::EpiMixT<(l) == 1>, pg8::StaticOrder, true, true, (l) == 1>(lds, g, S, E); \
            SEAM_DONE(2 * (l)); } } while (0)
#define PHASE_G2_0() do { if (IN(2)) { \
        SEAM_WAIT(0); \
        pg8::Gemm g{Y, W2T, M, D, D}; pg8::StaticOrder S; S.init(M, D, G, (int)blockIdx.x); \
        pg8::EpiRms<0> E{XB, nullptr, XB, SSQ, args.in[8], (unsigned long long*)(ws + WS_XSLOT), ctl + CW_TMO, 1u, (unsigned long long*)(ws + WS_XS2), (float*)(ws + WS_SA), (signed char*)(ws + WS_XQ)}; \
        pg8::gemm_phase<pg8::EpiRms<0>, pg8::StaticOrder, false, true>(lds, g, S, E); SEAM_DONE(1); } } while (0)
#define PHASE_G2_1(last) do { if (IN(4)) { \
        SEAM_WAIT(2); \
        pg8::Gemm g{Y, W2T + (size_t)D * D, M, D, D}; pg8::StaticOrder S; S.init(M, D, G, (int)blockIdx.x); \
        pg8::EpiRms<1> E{XB, args.out, nullptr, nullptr, args.in[8] + D, (unsigned long long*)(ws + WS_XSLOT) + (size_t)M * 4, ctl + CW_TMO, 2u, nullptr, nullptr, nullptr}; \
        pg8::gemm_phase<pg8::EpiRms<1>, pg8::StaticOrder, false, true>(lds, g, S, E); if (!(last)) GRID_BAR(); } } while (0)
#define P0_PARTNERS() do { if (quad && tid == 0) { \
        const unsigned c0 = (blockIdx.x & 7u) + 8u * ((blockIdx.x >> 3) & 7u); const unsigned mine = xb_xcc_id() + 1u; unsigned diff = 0u; \
        for (unsigned k = 0; k < 4; ++k) { unsigned v = 0u, sp = 0u; \
            while ((v = __hip_atomic_load(ctl + CW_XCC + c0 + 64u * k, __ATOMIC_RELAXED, __HIP_MEMORY_SCOPE_AGENT)) == 0u && ++sp < (1u << 16)) __builtin_amdgcn_s_sleep(1); \
            diff |= (v != mine) ? 1u : 0u; } \
        MISC[17] = diff; } \
    __syncthreads(); } while (0)
    PHASE_P0();
    PHASE_G1(0);
    PHASE_G2_0();
    PHASE_G1(1);
    PHASE_G2_1(true);
#undef PHASE_P0
#undef P0_PARTNERS
#undef SEAM_DONE
#undef SEAM_WAIT
#undef PHASE_G2_0
#undef PHASE_G2_1
    if (PROF_ID != 0 && blockIdx.x == PROF_BLOCK && tid == 0) {
        const unsigned long long t0 = __builtin_amdgcn_s_memrealtime();
#ifdef PROF_CLK
        const unsigned long long want = (unsigned long long)MISC[20] / 10u;
#else
        const unsigned long long want = (unsigned long long)MISC[20] * PROF_SCALE;
#endif

        while (__builtin_amdgcn_s_memrealtime() - t0 < want) __builtin_amdgcn_s_sleep(8);
    }
#undef PHASE_G1
#undef IN
#undef GRID_BAR
}

extern "C" void kernel_launch(void* const* d_in, const int* in_sizes, int n_in, void* d_out, int out_size, void* d_ws, size_t ws_size, hipStream_t stream) {
    static int grid = 0;
    if (grid == 0) {
        if (n_in != 9 || in_sizes[0] != M * D || out_size != M * D || ws_size < WS_END) { fprintf(stderr, "kernel_launch: unexpected shapes (n_in %d, in0 %d, out %d, ws %zu); nothing launched\n", n_in, n_in > 0 ? in_sizes[0] : -1, out_size, ws_size); grid = -1; return; }
        int dev = 0, cus = 0, per_cu = 0;
        if (hipGetDevice(&dev) != hipSuccess || hipDeviceGetAttribute(&cus, hipDeviceAttributeMultiprocessorCount, dev) != hipSuccess) { grid = -1; return; }
        if (hipFuncSetAttribute((const void*)mk_fwd, hipFuncAttributeMaxDynamicSharedMemorySize, LDS_BYTES) != hipSuccess) { fprintf(stderr, "kernel_launch: hipFuncSetAttribute failed\n"); grid = -1; return; }
        if (hipOccupancyMaxActiveBlocksPerMultiprocessor(&per_cu, (const void*)mk_fwd, NWAVES * 64, LDS_BYTES) != hipSuccess || per_cu < 1) fprintf(stderr, "kernel_launch: occupancy query reports %d blocks per CU\n", per_cu);
        (void)hipGetLastError();
        grid = cus;
        if (grid != 256) fprintf(stderr, "kernel_launch: %d CUs; the fused GEMM2 epilogue expects 256 workgroups\n", grid);
    }
    if (grid < 0) return;
    (void)hipMemsetAsync((char*)d_ws + WS_CTL, 0, CTL_ZERO_BYTES, stream);
    Args a{};
    for (int i = 0; i < 9; ++i) a.in[i] = (const float*)d_in[i];
    a.out = (float*)d_out; a.ws = (unsigned char*)d_ws;
    for (int li = 0; li < N_LAUNCHES; ++li) {
        a.ph_lo = (N_LAUNCHES == 1) ? 0 : li; a.ph_hi = (N_LAUNCHES == 1) ? N_PHASES : li + 1;
        hipLaunchKernelGGL(mk_fwd, dim3(grid), dim3(NWAVES * 64), LDS_BYTES, stream, a);
    }
}
```
